# Optimizing an MI355X kernel written in HIP

```python
import math
import jax, jax.numpy as jnp
from jax import lax
import numpy as np

D_MODEL = 2048
BATCH = 8
SEQ = 4096
DEPTH = 4

MIX_WIDTH = D_MODEL
GROUP_WIDTH = MIX_WIDTH // 4

RET_HEADS = 4
RET_DK = GROUP_WIDTH // (2 * RET_HEADS)
RET_DV = 2 * RET_DK
RET_CHUNK = 128

SSD_INNER = GROUP_WIDTH
SSD_HEADDIM = 64
SSD_HEADS = SSD_INNER // SSD_HEADDIM
SSD_GROUPS = 2
SSD_STATE = 128
SSD_CONV = 4
SSD_CHUNK = 128
SSD_CONV_DIM = SSD_INNER + 2 * SSD_GROUPS * SSD_STATE
DT_MIN = 1e-3
DT_MAX = 1e-1

DIFF_HEADS = 4
DIFF_HD = GROUP_WIDTH // (2 * DIFF_HEADS)
DIFF_QBLOCK = 128

DIL_HEADS = 8
DIL_HD = GROUP_WIDTH // DIL_HEADS
DIL_PATTERNS = ((128, 1), (512, 4), (2048, 16))

FFN_HIDDEN = -(-8 * D_MODEL // (3 * 256)) * 256

IN_SPLITS = (
    RET_HEADS * RET_DK,
    RET_HEADS * RET_DK,
    RET_HEADS * RET_DV,
    GROUP_WIDTH,
    SSD_INNER,
    SSD_CONV_DIM,
    SSD_HEADS,
    2 * DIFF_HEADS * DIFF_HD,
    2 * DIFF_HEADS * DIFF_HD,
    2 * DIFF_HEADS * DIFF_HD,
    DIL_HEADS * DIL_HD,
    DIL_HEADS * DIL_HD,
    DIL_HEADS * DIL_HD,
)
IN_COLS = sum(IN_SPLITS)
NORM_EPS = 1e-6

kernel_name = 'hybrid_parallel_head_group_block'


def rms_norm(x, g, eps=NORM_EPS):
    xf = x.astype(jnp.float32)
    y = xf * lax.rsqrt(jnp.mean(xf * xf, axis=-1, keepdims=True) + eps)
    return (y * g.astype(jnp.float32)).astype(x.dtype)


def alibi_slopes(n):
    return jnp.exp2(-8.0 * (jnp.arange(n, dtype=jnp.float32) + 1.0) / n)


def causal_depthwise_conv(x, w, b):
    K = w.shape[1]
    y = lax.conv_general_dilated(
        x, jnp.transpose(w)[:, None, :].astype(x.dtype), window_strides=(1,),
        padding=((K - 1, 0),), dimension_numbers=('NWC', 'WIO', 'NWC'),
        feature_group_count=x.shape[-1])
    return y + b.astype(x.dtype)


def retention(q, k, v, gain):
    Bsz, S, H, dk = q.shape
    dv = v.shape[-1]
    C = RET_CHUNK
    n = S // C
    dt = q.dtype
    log_gamma = jnp.log1p(-jnp.exp2(-5.0 - jnp.arange(H, dtype=jnp.float32)))
    pos = jnp.arange(C, dtype=jnp.float32)
    rel = pos[:, None] - pos[None, :]
    intra = jnp.where(rel >= 0, jnp.exp(log_gamma[:, None, None] * jnp.maximum(rel, 0.0)), 0.0).astype(dt)
    zeta = jnp.exp(log_gamma[None, :] * (C - 1.0 - pos)[:, None]).astype(dt)
    xi = jnp.exp(log_gamma[None, :] * (pos + 1.0)[:, None]).astype(dt)
    chunk_decay = jnp.exp(log_gamma * C).astype(dt)
    q = q.reshape(Bsz, n, C, H, dk)
    k = (k * (dk ** -0.5)).reshape(Bsz, n, C, H, dk)
    v = v.reshape(Bsz, n, C, H, dv)
    scores = jnp.einsum('bnihd,bnjhd->bnhij', q, k) * intra
    y_intra = jnp.einsum('bnhij,bnjhe->bnihe', scores, v)
    kv = jnp.einsum('bnjhd,jh,bnjhe->bnhde', k, zeta, v)

    def step(state, kv_c):
        return state * chunk_decay[None, :, None, None] + kv_c, state

    state0 = jnp.zeros((Bsz, H, dk, dv), dt)
    _, prev = lax.scan(step, state0, jnp.moveaxis(kv, 1, 0))
    prev = jnp.moveaxis(prev, 0, 1)
    y_cross = jnp.einsum('bnihd,bnhde->bnihe', q, prev) * xi[None, None, :, :, None]
    y = (y_intra + y_cross).reshape(Bsz, S, H, dv)
    return rms_norm(y, gain.reshape(H, dv))


def ssd_chunked_scan(xdt, a, bm, cm):
    Bsz, S, H, P = xdt.shape
    G, N = bm.shape[2], bm.shape[3]
    R = H // G
    L = SSD_CHUNK
    n = S // L
    dt = xdt.dtype
    x = xdt.reshape(Bsz, n, L, G, R, P)
    bm = bm.reshape(Bsz, n, L, G, N)
    cm = cm.reshape(Bsz, n, L, G, N)
    a = a.astype(jnp.float32).reshape(Bsz, n, L, G, R).transpose(0, 3, 4, 1, 2)
    a_cum = jnp.cumsum(a, axis=-1)
    causal = jnp.tril(jnp.ones((L, L), dtype=bool))
    seg = a_cum[..., :, None] - a_cum[..., None, :]
    decay_in = jnp.where(causal, jnp.exp(jnp.where(causal, seg, 0.0)), 0.0).astype(dt)
    cb = jnp.einsum('bclgn,bcsgn->bgcls', cm, bm)
    y_diag = jnp.einsum('bgcls,bgrcls,bcsgrp->bclgrp', cb, decay_in, x)
    decay_to_end = jnp.exp(a_cum[..., -1:] - a_cum).astype(dt)
    states = jnp.einsum('bcsgn,bgrcs,bcsgrp->bcgrpn', bm, decay_to_end, x)
    chunk_decay = jnp.exp(a_cum[..., -1]).astype(dt)

    def step(h, inp):
        st, dec = inp
        return h * dec[..., None, None] + st, h

    h0 = jnp.zeros((Bsz, G, R, P, N), dt)
    _, h_prev = lax.scan(step, h0, (jnp.moveaxis(states, 1, 0), jnp.moveaxis(chunk_decay, -1, 0)))
    h_prev = jnp.moveaxis(h_prev, 0, 1)
    decay_from_start = jnp.exp(a_cum).astype(dt)
    y_off = jnp.einsum('bclgn,bcgrpn,bgrcl->bclgrp', cm, h_prev, decay_from_start)
    return (y_diag + y_off).reshape(Bsz, S, H, P)


def diff_attention(q, k, v, lam, sub_gain, lam_init, slopes):
    Bsz, S, H, _, d = q.shape
    QB = DIFF_QBLOCK
    nb = S // QB
    scale = d ** -0.5
    q_blocks = q.reshape(Bsz, nb, QB, H, 2, d).transpose(1, 0, 2, 3, 4, 5)
    kpos = jnp.arange(S)

    def one_block(args):
        qb, bi = args
        qpos = bi * QB + jnp.arange(QB)
        dist = qpos[:, None] - kpos[None, :]
        bias = -slopes[:, None, None] * dist.astype(jnp.float32)
        s = jnp.einsum('bqhcd,bkhcd->bhcqk', qb, k).astype(jnp.float32) * scale + bias[None, :, None]
        s = jnp.where(dist >= 0, s, -jnp.inf)
        p = jax.nn.softmax(s, axis=-1)
        att = (p[:, :, 0] - lam * p[:, :, 1]).astype(v.dtype)
        return jnp.einsum('bhqk,bkhe->bqhe', att, v)

    out = lax.map(one_block, (q_blocks, jnp.arange(nb)))
    out = out.transpose(1, 0, 2, 3, 4).reshape(Bsz, S, H, 2 * d)
    return rms_norm(out, sub_gain) * (1.0 - lam_init)


def dilated_branch(q, k, v, slopes, window, dilation):
    Bsz, S, H, d = q.shape
    W = window // dilation
    unit = W * dilation
    Sp = -(-S // unit) * unit
    M = Sp // dilation
    nb = M // W

    def strided(t):
        t = jnp.pad(t, ((0, 0), (0, Sp - S), (0, 0), (0, 0)))
        return t.reshape(Bsz, M, dilation, H, d).transpose(0, 2, 1, 3, 4).reshape(Bsz, dilation, nb, W, H, d)

    def with_prev(t):
        prev = jnp.pad(t, ((0, 0), (0, 0), (1, 0), (0, 0), (0, 0), (0, 0)))[:, :, :-1]
        return jnp.concatenate([prev, t], axis=3)

    qs = strided(q)
    kk = with_prev(strided(k))
    vv = with_prev(strided(v))
    i = jnp.arange(W)
    j = jnp.arange(2 * W)
    steps = W + i[:, None] - j[None, :]
    first = jnp.arange(nb)[:, None, None] == 0
    valid = (steps >= 0) & (steps <= W) & ~(first & (j < W)[None, None, :])
    bias = -slopes[:, None, None] * (steps * dilation).astype(jnp.float32)
    s = jnp.einsum('brnqhd,brnkhd->brnhqk', qs, kk).astype(jnp.float32) * (d ** -0.5) + bias[None, None, None]
    s = jnp.where(valid[None, None, :, None], s, -jnp.inf)
    m = jnp.max(s, axis=-1, keepdims=True)
    p = jnp.exp(s - m)
    l = jnp.sum(p, axis=-1, keepdims=True)
    o = jnp.einsum('brnhqk,brnkhd->brnqhd', (p / l).astype(v.dtype), vv)
    lse = (m + jnp.log(l))[..., 0]
    o = o.reshape(Bsz, dilation, M, H, d).transpose(0, 2, 1, 3, 4).reshape(Bsz, Sp, H, d)[:, :S]
    lse = lse.transpose(0, 1, 2, 4, 3).reshape(Bsz, dilation, M, H).transpose(0, 2, 1, 3).reshape(Bsz, Sp, H)[:, :S]
    return o, lse


def dilated_attention(q, k, v, slopes):
    outs = []
    lses = []
    for window, dilation in DIL_PATTERNS:
        o, lse = dilated_branch(q, k, v, slopes, window, dilation)
        outs.append(o)
        lses.append(lse)
    wts = jax.nn.softmax(jnp.stack(lses, axis=0), axis=0)
    return jnp.einsum('pbsh,pbshd->bshd', wts.astype(q.dtype), jnp.stack(outs, axis=0))


def hybrid_mixer(h, layer, w_in, ret_norm, conv_w, conv_b, dt_bias, a_log, d_skip, ssd_norm_g, diff_lambda, diff_norm_g):
    Bsz, S, _ = h.shape
    split_points = np.cumsum(IN_SPLITS)[:-1].tolist()
    (r_q, r_k, r_v, r_g, s_z, s_xbc, s_dt, d_q, d_k, d_v, l_q, l_k, l_v) = jnp.split(h @ w_in, split_points, axis=-1)

    ret = retention(r_q.reshape(Bsz, S, RET_HEADS, RET_DK), r_k.reshape(Bsz, S, RET_HEADS, RET_DK),
                    r_v.reshape(Bsz, S, RET_HEADS, RET_DV), ret_norm)
    out_a = ret.reshape(Bsz, S, RET_HEADS * RET_DV) * jax.nn.silu(r_g)

    xbc = jax.nn.silu(causal_depthwise_conv(s_xbc, conv_w, conv_b))
    s_x, s_b, s_c = jnp.split(xbc, [SSD_INNER, SSD_INNER + SSD_GROUPS * SSD_STATE], axis=-1)
    s_x = s_x.reshape(Bsz, S, SSD_HEADS, SSD_HEADDIM)
    dt = jax.nn.softplus((s_dt + dt_bias).astype(jnp.float32))
    a = dt * (-jnp.exp(a_log.astype(jnp.float32)))
    y = ssd_chunked_scan(s_x * dt[..., None].astype(s_x.dtype), a,
                         s_b.reshape(Bsz, S, SSD_GROUPS, SSD_STATE), s_c.reshape(Bsz, S, SSD_GROUPS, SSD_STATE))
    y = y + s_x * d_skip[:, None].astype(s_x.dtype)
    y = (y.reshape(Bsz, S, SSD_INNER) * jax.nn.silu(s_z)).reshape(Bsz, S, SSD_GROUPS, SSD_INNER // SSD_GROUPS)
    out_b = rms_norm(y, ssd_norm_g.reshape(SSD_GROUPS, SSD_INNER // SSD_GROUPS)).reshape(Bsz, S, SSD_INNER)

    lam_init = 0.8 - 0.6 * math.exp(-0.3 * layer)
    lf = diff_lambda.astype(jnp.float32)
    lam = jnp.exp(jnp.sum(lf[0] * lf[1])) - jnp.exp(jnp.sum(lf[2] * lf[3])) + lam_init
    out_c = diff_attention(d_q.reshape(Bsz, S, DIFF_HEADS, 2, DIFF_HD), d_k.reshape(Bsz, S, DIFF_HEADS, 2, DIFF_HD),
                           d_v.reshape(Bsz, S, DIFF_HEADS, 2 * DIFF_HD), lam, diff_norm_g, lam_init,
                           alibi_slopes(DIFF_HEADS)).reshape(Bsz, S, 2 * DIFF_HEADS * DIFF_HD)

    out_d = dilated_attention(l_q.reshape(Bsz, S, DIL_HEADS, DIL_HD), l_k.reshape(Bsz, S, DIL_HEADS, DIL_HD),
                              l_v.reshape(Bsz, S, DIL_HEADS, DIL_HD), alibi_slopes(DIL_HEADS)).reshape(Bsz, S, DIL_HEADS * DIL_HD)

    return jnp.concatenate([out_a, out_b, out_c, out_d], axis=-1)


def setup_inputs(seed: int = 0) -> dict:
    key = jax.random.key(seed)
    ks = jax.random.split(key, 20)
    f32 = jnp.float32

    def nrm(k, shape, scale):
        return scale * jax.random.normal(k, shape, f32)

    def gain(k, shape):
        return 1.0 + 0.02 * jax.random.normal(k, shape, f32)

    x = jax.random.normal(ks[0], (BATCH, SEQ, D_MODEL), f32)
    norm_mix_pre = gain(ks[1], (DEPTH, D_MODEL))
    w_in = nrm(ks[2], (DEPTH, D_MODEL, IN_COLS), D_MODEL ** -0.5)
    ret_norm = gain(ks[3], (DEPTH, RET_HEADS * RET_DV))
    ssd_conv_w = nrm(ks[4], (DEPTH, SSD_CONV_DIM, SSD_CONV), SSD_CONV ** -0.5)
    ssd_conv_b = nrm(ks[5], (DEPTH, SSD_CONV_DIM), 0.02)
    dt0 = jnp.exp(jax.random.uniform(ks[6], (DEPTH, SSD_HEADS), f32, math.log(DT_MIN), math.log(DT_MAX)))
    ssd_dt_bias = dt0 + jnp.log(-jnp.expm1(-dt0))
    ssd_a_log = jnp.log(jax.random.uniform(ks[7], (DEPTH, SSD_HEADS), f32, 1.0, 16.0))
    ssd_d = gain(ks[8], (DEPTH, SSD_HEADS))
    ssd_norm = gain(ks[9], (DEPTH, SSD_INNER))
    diff_lambda = nrm(ks[10], (DEPTH, 4, DIFF_HD), 0.1)
    diff_norm = gain(ks[11], (DEPTH, 2 * DIFF_HD))
    w_out = nrm(ks[12], (DEPTH, MIX_WIDTH, D_MODEL), MIX_WIDTH ** -0.5)
    norm_mix_post = gain(ks[13], (DEPTH, D_MODEL))
    norm_ffn_pre = gain(ks[14], (DEPTH, D_MODEL))
    w_gate = nrm(ks[15], (DEPTH, D_MODEL, FFN_HIDDEN), D_MODEL ** -0.5)
    w_up = nrm(ks[16], (DEPTH, D_MODEL, FFN_HIDDEN), D_MODEL ** -0.5)
    w_down = nrm(ks[17], (DEPTH, FFN_HIDDEN, D_MODEL), FFN_HIDDEN ** -0.5)
    norm_ffn_post = gain(ks[18], (DEPTH, D_MODEL))
    return {'x': x, 'norm_mix_pre': norm_mix_pre, 'w_in': w_in, 'ret_norm': ret_norm,
            'ssd_conv_w': ssd_conv_w, 'ssd_conv_b': ssd_conv_b, 'ssd_dt_bias': ssd_dt_bias,
            'ssd_a_log': ssd_a_log, 'ssd_d': ssd_d, 'ssd_norm': ssd_norm, 'diff_lambda': diff_lambda,
            'diff_norm': diff_norm, 'w_out': w_out, 'norm_mix_post': norm_mix_post,
            'norm_ffn_pre': norm_ffn_pre, 'w_gate': w_gate, 'w_up': w_up, 'w_down': w_down,
            'norm_ffn_post': norm_ffn_post}


def reference(x, norm_mix_pre, w_in, ret_norm, ssd_conv_w, ssd_conv_b, ssd_dt_bias, ssd_a_log, ssd_d,
              ssd_norm, diff_lambda, diff_norm, w_out, norm_mix_post, norm_ffn_pre, w_gate, w_up, w_down,
              norm_ffn_post):
    for l in range(DEPTH):
        h = rms_norm(x, norm_mix_pre[l])
        mix = hybrid_mixer(h, l, w_in[l], ret_norm[l], ssd_conv_w[l], ssd_conv_b[l], ssd_dt_bias[l],
                           ssd_a_log[l], ssd_d[l], ssd_norm[l], diff_lambda[l], diff_norm[l])
        x = x + rms_norm(mix @ w_out[l], norm_mix_post[l])
        h = rms_norm(x, norm_ffn_pre[l])
        f = (jax.nn.silu(h @ w_gate[l]) * (h @ w_up[l])) @ w_down[l]
        x = x + rms_norm(f, norm_ffn_post[l])
    return x
```

```cpp
#include <hip/hip_runtime.h>
#include <cstdio>
#include <cstdint>

#ifndef MK_N_LAUNCHES
#define MK_N_LAUNCHES 1
#endif

namespace pg8 {
#define PG8_LAS __attribute__((address_space(3)))
typedef unsigned short bf16_t;
typedef short bf16x8 __attribute__((ext_vector_type(8)));
typedef float f32x4 __attribute__((ext_vector_type(4)));
typedef unsigned u32x4 __attribute__((ext_vector_type(4)));
constexpr int BM = 256, BK = 64, HALF = 128, HTB = HALF * BK * 2, STAGE_BYTES = 8 * HTB, NXCD = 8, WGM = 8;

__host__ __device__ __forceinline__ int lds_byte(int r, int c) { const int st = (r >> 4) * 2 + (c >> 5), rr = r & 15, cc = c & 31, ob = rr * 64 + cc * 2; return st * 1024 + (ob ^ (((ob >> 9) & 1) << 5)); }
__host__ __device__ __forceinline__ void stage_rc(int b, int& R, int& C) { const int st = b / 1024, sb = b % 1024, swz = sb ^ (((sb >> 9) & 1) << 5); R = (st >> 1) * 16 + swz / 64; C = (st & 1) * 32 + (swz % 64) / 2; }
__host__ __device__ __forceinline__ int perm32(int rho) { const int n = rho >> 4, i = rho & 15; return 8 * (i >> 2) + 4 * n + (i & 3); }

struct Unit { int pm, pn; };
struct Gemm { const bf16_t* A; const bf16_t* Bt; int M, N, K; };

struct StaticOrder {
    int nM, nN, nwg, G, c;
    __host__ __device__ void init(int M, int N, int G_, int c_) { nM = M / BM; nN = N / BM; nwg = nM * nN; G = G_; c = c_; }
    __host__ __device__ bool next(int i, Unit& u) const {
        const long L = (long)i * G + c; if (L >= nwg) return false;
        int wgid = (int)L; { const int q = nwg / NXCD, r = nwg % NXCD, xcd = wgid % NXCD, off = wgid / NXCD; wgid = (xcd < r ? xcd * (q + 1) : r * (q + 1) + (xcd - r) * q) + off; }
        const int nig = WGM * nN, gid = wgid / nig, fm = gid * WGM, gsz = (nM - fm) < WGM ? (nM - fm) : WGM;
        u.pm = fm + ((wgid % nig) % gsz); u.pn = (wgid % nig) / gsz; return true;
    }
    __device__ __forceinline__ void a_ready(const Unit&) const {}
    __device__ __forceinline__ void done(const Unit&) const {}
};

__device__ __forceinline__ unsigned cvt_pk_bf16(float lo, float hi) { unsigned r; asm volatile("v_cvt_pk_bf16_f32 %0, %1, %2" : "=v"(r) : "v"(lo), "v"(hi)); return r; }

struct EpiBf16 {
    static constexpr bool PERM = true, AFTER_DRAIN = false;
    bf16_t* O; int ldc;
    __device__ __forceinline__ void operator()(const f32x4 (&acc)[2][2][4][2], const Unit& u, int wr, int wc, int fr, int fq) const {
        const int row0 = u.pm * BM + wr * 64 + fr; const int col0 = u.pn * BM + wc * 32 + 8 * fq;
#pragma unroll
        for (int ai = 0; ai < 2; ++ai)
#pragma unroll
            for (int m = 0; m < 4; ++m) { bf16_t* rowp = O + (size_t)(row0 + ai * HALF + m * 16) * ldc + col0;
#pragma unroll
                for (int bj = 0; bj < 2; ++bj) { const f32x4 v0 = acc[ai][bj][m][0], v1 = acc[ai][bj][m][1];
                    u32x4 w; w.x = cvt_pk_bf16(v0[0], v0[1]); w.y = cvt_pk_bf16(v0[2], v0[3]); w.z = cvt_pk_bf16(v1[0], v1[1]); w.w = cvt_pk_bf16(v1[2], v1[3]);
                    *(u32x4*)(rowp + bj * HALF) = w; } }
    }
};
struct EpiProj {
    static constexpr bool PERM = true, AFTER_DRAIN = false;
    bf16_t* O; int ldc; bf16_t* C;
    __device__ __forceinline__ void operator()(const f32x4 (&acc)[2][2][4][2], const Unit& u, int wr, int wc, int fr, int fq) const {
        if (u.pn < 18) { EpiBf16 e{O, ldc}; e(acc, u, wr, wc, fr, fq); return; }
        const int sel = (u.pn - 18) >> 1, hb = ((u.pn - 18) & 1) * 4;
        const int row0 = u.pm * BM + wr * 64 + fr; const int c0 = wc * 32 + 8 * fq;
#pragma unroll
        for (int ai = 0; ai < 2; ++ai)
#pragma unroll
            for (int m = 0; m < 4; ++m) { const int row = row0 + ai * HALF + m * 16; const int b = row >> 12, t = row & 4095;
#pragma unroll
                for (int bj = 0; bj < 2; ++bj) { const int c = c0 + bj * HALF; const int h = hb + (c >> 6), d = c & 63;
                    bf16_t* dst = C + ((size_t)(((b * 8 + h) * 16 + (t & 15)) * 256 + (t >> 4))) * 192 + sel * 64 + d;
                    const f32x4 v0 = acc[ai][bj][m][0], v1 = acc[ai][bj][m][1];
                    u32x4 w; w.x = cvt_pk_bf16(v0[0], v0[1]); w.y = cvt_pk_bf16(v0[2], v0[3]); w.z = cvt_pk_bf16(v1[0], v1[1]); w.w = cvt_pk_bf16(v1[2], v1[3]);
                    *(u32x4*)dst = w; } }
    }
};
__device__ __forceinline__ float silu_mul(float g, float u) { return g * u * __builtin_amdgcn_rcpf(1.0f + __builtin_amdgcn_exp2f(-1.4426950408889634f * g)); }
struct EpiSwiGLU {
    static constexpr bool PERM = true, AFTER_DRAIN = false;
    bf16_t* O; int ldc;
    __device__ __forceinline__ void operator()(const f32x4 (&acc)[2][2][4][2], const Unit& u, int wr, int wc, int fr, int fq) const {
        const int row0 = u.pm * BM + wr * 64 + fr; const int col0 = u.pn * HALF + wc * 32 + 8 * fq;
#pragma unroll
        for (int ai = 0; ai < 2; ++ai)
#pragma unroll
            for (int m = 0; m < 4; ++m) { bf16_t* rowp = O + (size_t)(row0 + ai * HALF + m * 16) * ldc + col0;
                const f32x4 g0 = acc[ai][0][m][0], g1 = acc[ai][0][m][1], u0 = acc[ai][1][m][0], u1 = acc[ai][1][m][1];
                u32x4 w; w.x = cvt_pk_bf16(silu_mul(g0[0], u0[0]), silu_mul(g0[1], u0[1])); w.y = cvt_pk_bf16(silu_mul(g0[2], u0[2]), silu_mul(g0[3], u0[3]));
                w.z = cvt_pk_bf16(silu_mul(g1[0], u1[0]), silu_mul(g1[1], u1[1])); w.w = cvt_pk_bf16(silu_mul(g1[2], u1[2]), silu_mul(g1[3], u1[3]));
                *(u32x4*)rowp = w; }
    }
};

template <class Epi, class Sched, bool ALIGN_EPI = false, bool SP2 = false>
__device__ __forceinline__ void gemm_phase(PG8_LAS unsigned char* lds, const Gemm g, const Sched& S, const Epi& E) {
    int tid = threadIdx.x; asm volatile("" : "+v"(tid));
    const int wid = __builtin_amdgcn_readfirstlane(tid >> 6), lane = tid & 63, wr = wid >> 2, wc = wid & 3, fr = lane & 15, fq = lane >> 4;
    const int K = g.K, nt = K / BK;
    unsigned voffA[2], voffB[2];
#pragma unroll
    for (int i = 0; i < 2; ++i) { int R, C; stage_rc(tid * 16 + i * 8192, R, C); const int Rb = Epi::PERM ? ((R & ~31) + perm32(R & 31)) : R;
        voffA[i] = (unsigned)(R * K + C) * 2u; voffB[i] = (unsigned)(Rb * K + C) * 2u; }
    const size_t kstep = (size_t)(BK * 2);
    const size_t hstep = (size_t)HALF * K * 2;
    const size_t tstep = 2 * hstep;
    const unsigned ldsw = (unsigned)wid * 1024u;
    const int aoff = lds_byte(wr * 64 + fr, fq * 8), boff = lds_byte(wc * 32 + fr, fq * 8);
#define PG8_SA(b, h) (((b) * 2 + (h)) * HTB)
#define PG8_SB(b, h) ((4 + (b) * 2 + (h)) * HTB)
#define PG8_STAGE(bufoff, gbase, voff) do { _Pragma("unroll") for (int _i = 0; _i < 2; ++_i) \
        __builtin_amdgcn_global_load_lds((const unsigned*)((const char*)(gbase) + (voff)[_i]), (PG8_LAS unsigned*)(lds + (bufoff) + ldsw + _i * 8192), 16, 0, 0); } while (0)
#define PG8_LDA(dst, b, h) do { _Pragma("unroll") for (int m = 0; m < 4; ++m) _Pragma("unroll") for (int k = 0; k < 2; ++k) dst[m][k] = *(const PG8_LAS bf16x8*)(lds + PG8_SA(b, h) + aoff + m * 2048 + k * 1024); } while (0)
#define PG8_LDB(dst, b, h) do { _Pragma("unroll") for (int n = 0; n < 2; ++n) _Pragma("unroll") for (int k = 0; k < 2; ++k) dst[n][k] = *(const PG8_LAS bf16x8*)(lds + PG8_SB(b, h) + boff + n * 2048 + k * 1024); } while (0)
#define PG8_MMA(ai, bj, At, Bt) do { __builtin_amdgcn_s_setprio(1); _Pragma("unroll") for (int m = 0; m < 4; ++m) _Pragma("unroll") for (int n = 0; n < 2; ++n) _Pragma("unroll") for (int k = 0; k < 2; ++k) \
        acc[ai][bj][m][n] = __builtin_amdgcn_mfma_f32_16x16x32_bf16(Bt[n][k], At[m][k], acc[ai][bj][m][n], 0, 0, 0); __builtin_amdgcn_s_setprio(0); } while (0)
#define PG8_WAIT_V(n) asm volatile("s_waitcnt vmcnt(" #n ")" ::: "memory")
#define PG8_WAIT_L(n) asm volatile("s_waitcnt lgkmcnt(" #n ")" ::: "memory")
#define PG8_BAR __builtin_amdgcn_s_barrier()
#define PG8_SCHED __builtin_amdgcn_sched_barrier(0)
    Unit cur, nxt; int ui = 0;
    if (!S.next(0, cur)) return;
    f32x4 acc[2][2][4][2];
#pragma unroll
    for (int a = 0; a < 2; ++a)
#pragma unroll
        for (int b = 0; b < 2; ++b)
#pragma unroll
            for (int m = 0; m < 4; ++m)
#pragma unroll
                for (int n = 0; n < 2; ++n) acc[a][b][m][n] = (f32x4){0.f, 0.f, 0.f, 0.f};
    bf16x8 At[4][2], B0[2][2], B1[2][2];
    const char* cA = (const char*)g.A + (size_t)cur.pm * tstep; const char* cB = (const char*)g.Bt + (size_t)cur.pn * tstep;
    S.a_ready(cur);
    if constexpr (SP2) {
        PG8_STAGE(PG8_SB(0, 0), cB, voffB); PG8_STAGE(PG8_SB(0, 1), cB + hstep, voffB); PG8_STAGE(PG8_SA(0, 0), cA, voffA); PG8_STAGE(PG8_SA(0, 1), cA + hstep, voffA);
        if (wr == 1) PG8_BAR;
        PG8_WAIT_V(2); PG8_BAR;
        PG8_STAGE(PG8_SB(1, 0), cB + kstep, voffB); PG8_STAGE(PG8_SA(1, 0), cA + kstep, voffA); PG8_STAGE(PG8_SB(1, 1), cB + hstep + kstep, voffB);
        PG8_WAIT_V(6); PG8_BAR;
    } else {
        PG8_STAGE(PG8_SB(0, 0), cB, voffB); PG8_STAGE(PG8_SA(0, 0), cA, voffA); PG8_STAGE(PG8_SB(0, 1), cB + hstep, voffB); PG8_STAGE(PG8_SA(0, 1), cA + hstep, voffA);
        if (wr == 1) PG8_BAR;
        PG8_WAIT_V(4); PG8_BAR;
        PG8_STAGE(PG8_SB(1, 0), cB + kstep, voffB); PG8_STAGE(PG8_SA(1, 0), cA + kstep, voffA); PG8_STAGE(PG8_SB(1, 1), cB + hstep + kstep, voffB);
        PG8_WAIT_V(6); PG8_BAR;
    }
    for (;;) {
        const bool has_next = S.next(ui + 1, nxt);
        const char* nA = has_next ? (const char*)g.A + (size_t)nxt.pm * tstep : cA; const char* nB = has_next ? (const char*)g.Bt + (size_t)nxt.pn * tstep : cB;
        for (int t = 0; t < nt; t += 2) {
            const bool last = (t == nt - 2);
            const char* a1 = cA + (size_t)(t + 1) * kstep;
            const char* a2 = last ? nA : cA + (size_t)(t + 2) * kstep; const char* b2 = last ? nB : cB + (size_t)(t + 2) * kstep;
            const char* a3 = a2 + kstep; const char* b3 = b2 + kstep;
            if (last && has_next) S.a_ready(nxt);
            if constexpr (SP2) {
            PG8_LDB(B0, 0, 0); PG8_LDB(B1, 0, 1); PG8_SCHED; PG8_LDA(At, 0, 0); PG8_STAGE(PG8_SA(1, 1), a1 + hstep, voffA);
            PG8_WAIT_V(8); PG8_WAIT_L(0); PG8_BAR; PG8_MMA(0, 0, At, B0); PG8_MMA(0, 1, At, B1); PG8_BAR; PG8_SCHED;
            PG8_LDA(At, 0, 1); PG8_STAGE(PG8_SB(0, 0), b2, voffB); PG8_STAGE(PG8_SB(0, 1), b2 + hstep, voffB); PG8_STAGE(PG8_SA(0, 0), a2, voffA);
            PG8_WAIT_V(8); PG8_WAIT_L(0); PG8_BAR; PG8_MMA(1, 0, At, B0); PG8_MMA(1, 1, At, B1); PG8_BAR; PG8_SCHED;
            PG8_LDB(B0, 1, 0); PG8_LDB(B1, 1, 1); PG8_SCHED; PG8_LDA(At, 1, 0); PG8_STAGE(PG8_SA(0, 1), a2 + hstep, voffA);
            PG8_WAIT_V(8); PG8_WAIT_L(0); PG8_BAR; PG8_MMA(0, 0, At, B0); PG8_MMA(0, 1, At, B1); PG8_BAR; PG8_SCHED;
            PG8_LDA(At, 1, 1); PG8_STAGE(PG8_SB(1, 0), b3, voffB); PG8_STAGE(PG8_SB(1, 1), b3 + hstep, voffB); PG8_STAGE(PG8_SA(1, 0), a3, voffA);
            PG8_WAIT_V(8); PG8_WAIT_L(0); PG8_BAR; PG8_MMA(1, 0, At, B0); PG8_MMA(1, 1, At, B1); PG8_BAR; PG8_SCHED;
            } else {
            PG8_LDB(B0, 0, 0); PG8_SCHED; PG8_LDA(At, 0, 0); PG8_STAGE(PG8_SA(1, 1), a1 + hstep, voffA);
            PG8_WAIT_L(8); PG8_BAR; PG8_WAIT_L(0); PG8_MMA(0, 0, At, B0); PG8_BAR; PG8_SCHED;
            PG8_LDB(B1, 0, 1); PG8_STAGE(PG8_SB(0, 0), b2, voffB);
            PG8_BAR; PG8_WAIT_L(0); PG8_MMA(0, 1, At, B1); PG8_BAR;
            PG8_LDA(At, 0, 1); PG8_STAGE(PG8_SA(0, 0), a2, voffA);
            PG8_BAR; PG8_WAIT_L(0); PG8_MMA(1, 0, At, B0); PG8_BAR; PG8_SCHED;
            PG8_STAGE(PG8_SB(0, 1), b2 + hstep, voffB);
            PG8_WAIT_V(6); PG8_BAR; PG8_MMA(1, 1, At, B1); PG8_BAR;
            PG8_LDB(B0, 1, 0); PG8_SCHED; PG8_LDA(At, 1, 0); PG8_STAGE(PG8_SA(0, 1), a2 + hstep, voffA);
            PG8_WAIT_L(8); PG8_BAR; PG8_WAIT_L(0); PG8_MMA(0, 0, At, B0); PG8_BAR; PG8_SCHED;
            PG8_LDB(B1, 1, 1); PG8_STAGE(PG8_SB(1, 0), b3, voffB);
            PG8_BAR; PG8_WAIT_L(0); PG8_MMA(0, 1, At, B1); PG8_BAR;
            PG8_LDA(At, 1, 1); PG8_STAGE(PG8_SA(1, 0), a3, voffA);
            PG8_BAR; PG8_WAIT_L(0); PG8_MMA(1, 0, At, B0); PG8_BAR; PG8_SCHED;
            PG8_STAGE(PG8_SB(1, 1), b3 + hstep, voffB);
            PG8_WAIT_V(6); PG8_BAR; PG8_MMA(1, 1, At, B1); PG8_BAR;
            }
        }
        if constexpr (ALIGN_EPI) { if (wr == 0) PG8_BAR; }
        if constexpr (!Epi::AFTER_DRAIN) { E(acc, cur, wr, wc, fr, fq); S.done(cur); }
        if (!has_next) break;
#pragma unroll
        for (int a = 0; a < 2; ++a)
#pragma unroll
            for (int b = 0; b < 2; ++b)
#pragma unroll
                for (int m = 0; m < 4; ++m)
#pragma unroll
                    for (int n = 0; n < 2; ++n) acc[a][b][m][n] = (f32x4){0.f, 0.f, 0.f, 0.f};
        cur = nxt; cA = nA; cB = nB; ++ui;
        if constexpr (ALIGN_EPI) { if (wr == 1) PG8_BAR; }
    }
    PG8_WAIT_V(0);
    if constexpr (!ALIGN_EPI) { if (wr == 0) PG8_BAR; }
    PG8_BAR;
#undef PG8_SA
#undef PG8_SB
#undef PG8_STAGE
#undef PG8_LDA
#undef PG8_LDB
#undef PG8_MMA
#undef PG8_WAIT_V
#undef PG8_WAIT_L
#undef PG8_BAR
#undef PG8_SCHED
}
}

constexpr int NWAVES = 8;
constexpr int BATCH = 8, SEQ = 4096, DM = 2048, DEPTH = 4;
constexpr int M = BATCH * SEQ;
constexpr int IN_COLS = 6152, LDP = 6144;
constexpr int FFN = 5632;
constexpr float NORM_EPS = 1e-6f;
constexpr int C_RQ = 0, C_RK = 256, C_RV = 512, C_RG = 1024, C_SZ = 1536, C_SXBC = 2048, C_DQ = 3072, C_DK = 3584, C_DV = 4096, C_LQ = 4608, C_LK = 5120, C_LV = 5632, C_DT = 6144;
constexpr int N_PHASES = 1 + 7 * DEPTH;

constexpr size_t MiB = 1u << 20;
constexpr size_t WS_CTL = 0, CTL_ZERO_BYTES = 1 * MiB;
constexpr size_t WS_W0 = 2 * MiB, WBUF = 99 * MiB, WO_IN = 0, WO_OUT = 25 * MiB, WO_GU = 33 * MiB, WO_D = 77 * MiB;
constexpr size_t WS_MIX = 200 * MiB, WS_PROJ = 328 * MiB, WS_XB = 728 * MiB, WS_DT = 856 * MiB, WS_RINV = 857 * MiB, WS_DQKV = 858 * MiB, WS_END = 954 * MiB;
constexpr size_t OS_DILO = 0, OS_DILL = 64 * MiB, OS_SSDS = 66 * MiB, OS_SSDL = 82 * MiB, OS_RETS = 83 * MiB;
constexpr int CW_BAR = 4096, CW_Q = 16384, CW_FLAG = 32768, CW_FLAG2 = 65536, CW_FLAG3 = 131072, CW_KNF = 196608, CW_KN = 204800;

constexpr int RING_OFF = 0, RING_BYTES = 131072;
constexpr int LDSCTL_OFF = RING_BYTES, MISC_OFF = LDSCTL_OFF + 320;
constexpr int LDS_BYTES = 147456;

#define GAS __attribute__((address_space(1)))
#define LAS __attribute__((address_space(3)))
typedef unsigned short bf16;
typedef unsigned v4u __attribute__((ext_vector_type(4)));
typedef unsigned v2u __attribute__((ext_vector_type(2)));
typedef float f32x4 __attribute__((ext_vector_type(4)));
typedef GAS unsigned gu32;
#define RLX_AGENT __ATOMIC_RELAXED, __HIP_MEMORY_SCOPE_AGENT
#define LDS_WAIT() asm volatile("s_waitcnt lgkmcnt(0)" ::: "memory")
#define VM_WAIT() asm volatile("s_waitcnt vmcnt(0)" ::: "memory")
__device__ __forceinline__ unsigned f2bf(float f) { unsigned u = __builtin_bit_cast(unsigned, f); return (u + 0x7fffu + ((u >> 16) & 1u)) >> 16; }
__device__ __forceinline__ unsigned pk2(float lo, float hi) { return f2bf(lo) | (f2bf(hi) << 16); }
__device__ __forceinline__ float bflo(unsigned w) { return __uint_as_float(w << 16); }
__device__ __forceinline__ float bfhi(unsigned w) { return __uint_as_float(w & 0xffff0000u); }
__device__ __forceinline__ float ldbf(const bf16* p) { return __uint_as_float(((unsigned)*p) << 16); }
__device__ __forceinline__ float silu_f(float x) { return x / (1.f + __expf(-x)); }

#define XB_TMO      128
#define XB_XCNT(j)  (256  + 64 * (j))
#define XB_XSUB(j)  (1280 + 64 * (j))
#define XB_XGEN(j)  (2304 + 64 * (j))
#define XB_TOP      3328
#define XB_TOPGEN   3392
#define XCD_BAR_WORDS 3456
#define XB_SPIN_CAP (1u << 18)
__device__ __forceinline__ unsigned xb_ld(unsigned* p)              { return __hip_atomic_load(p, __ATOMIC_RELAXED, __HIP_MEMORY_SCOPE_AGENT); }
__device__ __forceinline__ unsigned xb_add(unsigned* p, unsigned v) { return __hip_atomic_fetch_add(p, v, __ATOMIC_RELAXED, __HIP_MEMORY_SCOPE_AGENT); }
__device__ __forceinline__ unsigned xb_xcc_id() { return (unsigned)__builtin_amdgcn_s_getreg((3 << 11) | 20) & 0xFu; }
#define XB_SPIN(cond, bar) do { unsigned _sp = 0; while (cond) { __builtin_amdgcn_s_sleep(1); \
    if ((++_sp & 255u) == 0u) { if (xb_ld(&(bar)[XB_TMO])) break; if (_sp > XB_SPIN_CAP) { atomicAdd(&(bar)[XB_TMO], 1u); break; } } } } while (0)
struct XcdBarrier { unsigned* bar; unsigned x; volatile LAS unsigned* st; };
__device__ __forceinline__ XcdBarrier xcd_barrier_post(unsigned* bar, volatile LAS unsigned* st) {
    XcdBarrier b; b.bar = bar; b.x = xb_xcc_id(); b.st = st;
    if (threadIdx.x == 0) (void)xb_add(&bar[XB_XCNT(b.x)], 1u);
    return b;
}
__device__ __forceinline__ void xcd_barrier_complete(unsigned* bar, unsigned x, unsigned& nloc, unsigned& nx) {
    const unsigned G = gridDim.x * gridDim.y * gridDim.z;
    unsigned sum, cnt, mine, sp = 0u;
    for (;;) {
        sum = 0u; cnt = 0u; mine = 0u;
#pragma unroll
        for (unsigned j = 0; j < 16; ++j) { const unsigned c = xb_ld(&bar[XB_XCNT(j)]); sum += c; cnt += (c > 0u) ? 1u : 0u; mine = (j == x) ? c : mine; }
        if (sum == G) break;
        __builtin_amdgcn_s_sleep(1);
        if ((++sp & 255u) == 0u) { if (xb_ld(&bar[XB_TMO])) break; if (sp > XB_SPIN_CAP) { atomicAdd(&bar[XB_TMO], 1u); break; } }
    }
    nloc = mine > 0u ? mine : 1u; nx = cnt > 0u ? cnt : 1u;
}
__device__ __forceinline__ void xcd_barrier(const XcdBarrier& b) {
    asm volatile("s_waitcnt vmcnt(0)" ::: "memory");
    __syncthreads();
    if (threadIdx.x == 0) {
        unsigned* bar = b.bar;
        __builtin_amdgcn_s_waitcnt(0);
        unsigned nloc = b.st[0], nx = b.st[1];
        if (nloc == 0u) { xcd_barrier_complete(bar, b.x, nloc, nx); b.st[0] = nloc; b.st[1] = nx; }
        const unsigned old = xb_add(&bar[XB_XSUB(b.x)], 1u);
        const unsigned gen = old / nloc;
        if (old + 1u == (gen + 1u) * nloc) {
            __builtin_amdgcn_fence(__ATOMIC_RELEASE, "agent");
            asm volatile("s_waitcnt vmcnt(0)" ::: "memory");
            const unsigned og = xb_add(&bar[XB_TOP], 1u);
            const unsigned tg = og / nx;
            if (og + 1u == (tg + 1u) * nx) xb_add(&bar[XB_TOPGEN], 1u);
            else XB_SPIN(xb_ld(&bar[XB_TOPGEN]) == tg, bar);
            __builtin_amdgcn_fence(__ATOMIC_ACQUIRE, "agent");
            xb_add(&bar[XB_XGEN(b.x)], 1u);
            asm volatile("s_waitcnt vmcnt(0)" ::: "memory");
        } else {
            XB_SPIN(xb_ld(&bar[XB_XGEN(b.x)]) == gen, bar);
            __builtin_amdgcn_fence(__ATOMIC_ACQUIRE, "agent");
            asm volatile("s_waitcnt vmcnt(0)" ::: "memory");
        }
    }
    __syncthreads();
}

struct Args { const float* in[19]; float* out; unsigned char* ws; int ph_lo, ph_hi, li, pad; };

__device__ __forceinline__ float wave_sum(float v) {
#pragma unroll
    for (int o = 1; o < 64; o <<= 1) v += __shfl_xor(v, o);
    return v;
}


template <int CTRL> __device__ __forceinline__ float dppf(float v) { return __builtin_bit_cast(float, __builtin_amdgcn_update_dpp(0, __builtin_bit_cast(int, v), CTRL, 0xf, 0xf, true)); }
#define DPP_X1(v) dppf<0xB1>(v)
#define DPP_X2(v) dppf<0x4E>(v)
#define DPP_HM(v) dppf<0x141>(v)
#define DPP_RM(v) dppf<0x140>(v)
#define SWZ_XORF(v, k) __builtin_bit_cast(float, __builtin_amdgcn_ds_swizzle(__builtin_bit_cast(int, (float)(v)), ((k) << 10) | 0x1f))
__device__ __forceinline__ float swap32_sum(float v) { auto rr = __builtin_amdgcn_permlane32_swap(__builtin_bit_cast(unsigned, v), __builtin_bit_cast(unsigned, v), false, false); const unsigned r0 = rr[0], r1 = rr[1]; return __builtin_bit_cast(float, r0) + __builtin_bit_cast(float, r1); }

typedef float f32x2_t __attribute__((ext_vector_type(2)));
typedef __bf16 bf16x2_t __attribute__((ext_vector_type(2)));
__device__ __forceinline__ unsigned cvtpk(float lo, float hi) { f32x2_t v = {lo, hi}; bf16x2_t b = __builtin_convertvector(v, bf16x2_t); return __builtin_bit_cast(unsigned, b); }
__device__ __forceinline__ unsigned cvtpk1(float v) { return cvtpk(v, v) & 0xffffu; }
__device__ __forceinline__ float wave_sum_fast(float d) { d += DPP_X1(d); d += DPP_X2(d); d += DPP_HM(d); d += DPP_RM(d); d += SWZ_XORF(d, 16); return swap32_sum(d); }

struct CvtItem { const float* src; bf16* dst; const float* gain; int ldw, K; };
constexpr int CVT_I_IN = 192 * 32, CVT_I_OUT = 64 * 32, CVT_I_G = 176 * 32, CVT_I_D = 64 * 88, CVT_NITEMS = CVT_I_IN + CVT_I_OUT + 2 * CVT_I_G + CVT_I_D;
__device__ __forceinline__ CvtItem cvt_decode(const Args& a, int l, int it) {
    const float* Win = a.in[2] + (size_t)l * DM * IN_COLS; const float* Wout = a.in[12] + (size_t)l * DM * DM;
    const float* Wg = a.in[15] + (size_t)l * DM * FFN; const float* Wu = a.in[16] + (size_t)l * DM * FFN; const float* Wd = a.in[17] + (size_t)l * FFN * DM;
    unsigned char* wb = a.ws + WS_W0 + (size_t)(l & 1) * WBUF;
    bf16* WinT = (bf16*)(wb + WO_IN); bf16* WoutT = (bf16*)(wb + WO_OUT); bf16* WguT = (bf16*)(wb + WO_GU); bf16* WdT = (bf16*)(wb + WO_D);
    const float* gmix = a.in[1] + l * DM; const float* gffn = a.in[14] + l * DM;
    CvtItem c; int r = it;
    if (r < CVT_I_IN) { const int kb = r / 192, nb = r % 192; const int sc = nb < 96 ? 32 * nb : 3080 + 32 * (nb - 96);
        c.src = Win + (size_t)(64 * kb) * IN_COLS + sc; c.ldw = IN_COLS; c.dst = WinT + (size_t)(32 * nb) * DM + 64 * kb; c.K = DM; c.gain = gmix + 64 * kb; return c; } r -= CVT_I_IN;
    if (r < CVT_I_OUT) { const int kb = r / 64, nb = r % 64; c.src = Wout + (size_t)(64 * kb) * DM + 32 * nb; c.ldw = DM; c.dst = WoutT + (size_t)(32 * nb) * DM + 64 * kb; c.K = DM; c.gain = nullptr; return c; } r -= CVT_I_OUT;
    if (r < 2 * CVT_I_G) { const int up = r >= CVT_I_G ? 1 : 0; r -= up * CVT_I_G; const int kb = r / 176, nb = r % 176, n0 = 32 * nb;
        c.src = (up ? Wu : Wg) + (size_t)(64 * kb) * FFN + n0; c.ldw = FFN; c.dst = WguT + (size_t)((n0 >> 7) * 256 + up * 128 + (n0 & 127)) * DM + 64 * kb; c.K = DM; c.gain = gffn + 64 * kb; return c; } r -= 2 * CVT_I_G;
    { const int kb = r / 64, nb = r % 64; c.src = Wd + (size_t)(64 * kb) * DM + 32 * nb; c.ldw = DM; c.dst = WdT + (size_t)(32 * nb) * FFN + 64 * kb; c.K = FFN; c.gain = nullptr; return c; }
}
__device__ __forceinline__ void convert_weights(const Args& a, int l, LAS unsigned char* lds, int it0, int it1, int step, int wave, int lane) {
    asm volatile("" : "+v"(lane));
    LAS float* scr = (LAS float*)(lds + RING_OFF + wave * 16384);
    const int kk = lane >> 3, c4 = (lane & 7) * 4, ch = lane & 7;
    if (it0 >= it1) return;
    CvtItem cur = cvt_decode(a, l, it0); f32x4 v[8];
#define CVT_LOAD(c_) do { const float* s_ = (c_).src + (size_t)kk * (c_).ldw + c4; _Pragma("unroll") for (int i = 0; i < 8; ++i) v[i] = *(const f32x4*)(s_ + (size_t)(8 * i) * (c_).ldw); } while (0)
    CVT_LOAD(cur);
    for (int it = it0; it < it1; it += step) {
#pragma unroll
        for (int i = 0; i < 8; ++i) { LAS float* d = scr + (8 * i + kk) * 33 + c4; d[0] = v[i].x; d[1] = v[i].y; d[2] = v[i].z; d[3] = v[i].w; }
        const CvtItem me = cur;
        if (it + step < it1) { cur = cvt_decode(a, l, it + step); CVT_LOAD(cur); }
        LDS_WAIT(); asm volatile("" ::: "memory");
        f32x4 g0 = (f32x4){1.f, 1.f, 1.f, 1.f}, g1 = g0;
        if (me.gain) { g0 = *(const f32x4*)(me.gain + 8 * ch); g1 = *(const f32x4*)(me.gain + 8 * ch + 4); }
#pragma unroll
        for (int j = 0; j < 4; ++j) { const int n = (lane >> 3) + 8 * j; const LAS float* sp = scr + (8 * ch) * 33 + n;
            v4u o; o.x = cvtpk(sp[0 * 33] * g0.x, sp[1 * 33] * g0.y); o.y = cvtpk(sp[2 * 33] * g0.z, sp[3 * 33] * g0.w); o.z = cvtpk(sp[4 * 33] * g1.x, sp[5 * 33] * g1.y); o.w = cvtpk(sp[6 * 33] * g1.z, sp[7 * 33] * g1.w);
            *(GAS v4u*)(me.dst + (size_t)n * me.K + 8 * ch) = o; }
        LDS_WAIT(); asm volatile("" ::: "memory");
    }
#undef CVT_LOAD
}

template <int KIND>
__device__ __forceinline__ void thin_rows(const float* xin32, bf16* Hn, float* rinv, const bf16* y, const float* g_post, float* xout32, int gw, int NGW, int lane,
                                          const float* wdt_src = nullptr, const float* g_dt = nullptr, float* dtout = nullptr, LAS unsigned char* lds = nullptr) {
    asm volatile("" : "+v"(lane));
    if (wdt_src) { __syncthreads();
        for (int i = threadIdx.x; i < 8 * DM; i += NWAVES * 64) { const int k = i >> 3, n = i & 7; ((LAS float*)lds)[n * DM + k] = wdt_src[(size_t)k * IN_COLS + n] * g_dt[k]; }
        __syncthreads(); }
    f32x4 gp[8];
#pragma unroll
    for (int j = 0; j < 8; ++j) gp[j] = (KIND != 0) ? ((const GAS f32x4*)g_post)[lane + 64 * j] : (f32x4){0.f, 0.f, 0.f, 0.f};
    f32x4 x32A[KIND == 0 ? 8 : 1]; v2u x16A[KIND == 0 ? 1 : 8]; v2u yA[8]; float riA = 1.f;
#define THIN_LOAD(x32, x16, yr, ri, m_) do { \
        if (KIND == 0) { const GAS f32x4* xp_ = (const GAS f32x4*)(xin32 + (size_t)(m_) * DM) + lane; _Pragma("unroll") for (int j = 0; j < 8; ++j) x32[KIND == 0 ? j : 0] = __builtin_nontemporal_load(&xp_[64 * j]); } \
        else { const GAS v2u* xp_ = (const GAS v2u*)(Hn + (size_t)(m_) * DM) + lane; _Pragma("unroll") for (int j = 0; j < 8; ++j) x16[KIND == 0 ? 0 : j] = __builtin_nontemporal_load(&xp_[64 * j]); ri = rinv[m_]; \
               const GAS v2u* yp_ = (const GAS v2u*)(y + (size_t)(m_) * DM) + lane; _Pragma("unroll") for (int j = 0; j < 8; ++j) yr[j] = __builtin_nontemporal_load(&yp_[64 * j]); } } while (0)
#define THIN_ROW(x32, x16, yr, ri) do { \
        f32x4 v[8]; \
        _Pragma("unroll") for (int j = 0; j < 8; ++j) { if (KIND == 0) v[j] = x32[KIND == 0 ? j : 0]; else { const v2u w = x16[KIND == 0 ? 0 : j]; v[j] = (f32x4){bflo(w.x), bfhi(w.x), bflo(w.y), bfhi(w.y)} * ri; } } \
        f32x4 yv[8]; float s = 0.f; \
        if (KIND != 0) { _Pragma("unroll") for (int j = 0; j < 8; ++j) { const v2u w = yr[j]; yv[j] = (f32x4){bflo(w.x), bfhi(w.x), bflo(w.y), bfhi(w.y)}; s += (yv[j].x * yv[j].x + yv[j].y * yv[j].y) + (yv[j].z * yv[j].z + yv[j].w * yv[j].w); } } \
        if (m + NGW < M) THIN_LOAD(x32, x16, yr, ri, m + NGW); \
        if (KIND != 0) { const float r1 = __builtin_amdgcn_rsqf(wave_sum_fast(s) * (1.f / DM) + NORM_EPS); \
            _Pragma("unroll") for (int j = 0; j < 8; ++j) v[j] = v[j] + yv[j] * r1 * gp[j]; } \
        if (KIND == 2) { GAS f32x4* xo = (GAS f32x4*)(xout32 + (size_t)m * DM) + lane; _Pragma("unroll") for (int j = 0; j < 8; ++j) xo[64 * j] = v[j]; } \
        else { float s2 = 0.f; \
            _Pragma("unroll") for (int j = 0; j < 8; ++j) s2 += (v[j].x * v[j].x + v[j].y * v[j].y) + (v[j].z * v[j].z + v[j].w * v[j].w); \
            const float ms = wave_sum_fast(s2) * (1.f / DM) + NORM_EPS; const float r2 = __builtin_amdgcn_rsqf(ms); \
            GAS v2u* ho = (GAS v2u*)(Hn + (size_t)m * DM) + lane; \
            _Pragma("unroll") for (int j = 0; j < 8; ++j) { v[j] = v[j] * r2; v2u w; w.x = cvtpk(v[j].x, v[j].y); w.y = cvtpk(v[j].z, v[j].w); ho[64 * j] = w; } \
            if (lane == 0) rinv[m] = ms * r2; \
            if (wdt_src) { \
                _Pragma("nounroll") for (int n = 0; n < 8; ++n) {          \
                    const LAS f32x4* wp = (const LAS f32x4*)(lds + (size_t)n * DM * 4) + lane; float d = 0.f; \
                    _Pragma("unroll") for (int j = 0; j < 8; ++j) { const f32x4 wv = wp[64 * j]; d += (v[j].x * wv.x + v[j].y * wv.y) + (v[j].z * wv.z + v[j].w * wv.w); } \
                    d = wave_sum_fast(d); if (lane == 0) dtout[(size_t)m * 8 + n] = d; } } } } while (0)
    int m = gw;
    if (m < M) THIN_LOAD(x32A, x16A, yA, riA, m);
    for (; m < M; m += NGW) { THIN_ROW(x32A, x16A, yA, riA); }
#undef THIN_LOAD
#undef THIN_ROW
}

typedef short bf16x8 __attribute__((ext_vector_type(8)));
typedef short s16x4 __attribute__((ext_vector_type(4)));
typedef short v4i16_t __attribute__((ext_vector_type(4)));
typedef float f32x16 __attribute__((ext_vector_type(16)));
typedef LAS const char* lds_cptr;
__device__ __forceinline__ int crow(int r, int hi) { return (r & 3) + 8 * (r >> 2) + 4 * hi; }
__device__ __forceinline__ s16x4 vtr(lds_cptr p) { return __builtin_bit_cast(s16x4, __builtin_amdgcn_ds_read_tr16_b64_v4i16((LAS v4i16_t*)p)); }
__device__ __forceinline__ bf16x8 tr_frag(lds_cptr p, int off2) { const s16x4 lo = vtr(p), hi = vtr(p + off2); return (bf16x8){lo[0], lo[1], lo[2], lo[3], hi[0], hi[1], hi[2], hi[3]}; }
__device__ __forceinline__ bf16x8 pack8(const f32x16& p, int s) { v4u w; w.x = cvtpk(p[8 * s + 0], p[8 * s + 1]); w.y = cvtpk(p[8 * s + 2], p[8 * s + 3]); w.z = cvtpk(p[8 * s + 4], p[8 * s + 5]); w.w = cvtpk(p[8 * s + 6], p[8 * s + 7]); return __builtin_bit_cast(bf16x8, w); }
#define MFMA32(a, b, c) __builtin_amdgcn_mfma_f32_32x32x16_bf16((a), (b), (c), 0, 0, 0)

__device__ __forceinline__ float swap32_max(float v) { auto rr = __builtin_amdgcn_permlane32_swap(__builtin_bit_cast(unsigned, v), __builtin_bit_cast(unsigned, v), false, false); const unsigned r0 = rr[0], r1 = rr[1]; return fmaxf(__builtin_bit_cast(float, r0), __builtin_bit_cast(float, r1)); }
__device__ __forceinline__ float swap32_min(float v) { auto rr = __builtin_amdgcn_permlane32_swap(__builtin_bit_cast(unsigned, v), __builtin_bit_cast(unsigned, v), false, false); const unsigned r0 = rr[0], r1 = rr[1]; return fminf(__builtin_bit_cast(float, r0), __builtin_bit_cast(float, r1)); }
__device__ __forceinline__ float bpermx_f(int src_lane, float v) { return __builtin_bit_cast(float, __builtin_amdgcn_ds_bpermute(src_lane << 2, __builtin_bit_cast(int, v))); }
__device__ __forceinline__ float max3a(float a, float b, float c) { float r; asm("v_max3_f32 %0, %1, %2, %3" : "=v"(r) : "v"(a), "v"(b), "v"(c)); return r; }
__device__ __forceinline__ float max2a(float a, float b) { float r; asm("v_max_f32_e32 %0, %1, %2" : "=v"(r) : "v"(a), "v"(b)); return r; }
__device__ __forceinline__ void kn_unit(const Args& a, int l, int b, int h, int tid) {
    asm volatile("" : "+v"(tid));
    const int lane = tid & 63;
    const bf16* P = (const bf16*)(a.ws + WS_PROJ) + (size_t)b * SEQ * LDP + C_DK + h * 128 + (tid & 15) * 8;
    float mx = 0.f;
    for (int r0 = tid >> 4; r0 < SEQ; r0 += 128) {
        v4u w[4];
#pragma unroll
        for (int i = 0; i < 4; ++i) w[i] = *(const v4u*)(P + (size_t)(r0 + 32 * i) * LDP);
#pragma unroll
        for (int i = 0; i < 4; ++i) { float k2 = 0.f;
#pragma unroll
            for (int k = 0; k < 4; ++k) k2 += bflo(w[i][k]) * bflo(w[i][k]) + bfhi(w[i][k]) * bfhi(w[i][k]);
            k2 += DPP_X1(k2); k2 += DPP_X2(k2); k2 += DPP_HM(k2);
            mx = fmaxf(mx, k2); } }
    mx = fmaxf(mx, SWZ_XORF(mx, 16)); mx = swap32_max(mx);
    unsigned* kn = (unsigned*)(a.ws + WS_CTL) + CW_KN + (size_t)((l * 16 + b * 2 + h) * 2) * 16;
    if (lane == 0 || lane == 8) __hip_atomic_fetch_max(kn + (lane >> 3) * 16, __builtin_bit_cast(unsigned, mx), __ATOMIC_RELAXED, __HIP_MEMORY_SCOPE_AGENT);
    asm volatile("s_waitcnt vmcnt(0)" ::: "memory");
    __syncthreads();
    if (tid == 0) { __builtin_amdgcn_fence(__ATOMIC_RELEASE, "agent"); asm volatile("s_waitcnt vmcnt(0)" ::: "memory");
        __hip_atomic_store((unsigned*)(a.ws + WS_CTL) + CW_KNF + (size_t)(l * 16 + b * 2 + h) * 64, 1u, __ATOMIC_RELAXED, __HIP_MEMORY_SCOPE_AGENT); }
}
__device__ __forceinline__ void diff_unit_mfma(const Args& a, int l, int b, int h, int qb, float lam, float lam_init, LAS unsigned char* lds, int tid) {
    asm volatile("" : "+v"(tid));
    const int lane = tid & 63, wave = __builtin_amdgcn_readfirstlane(tid >> 6), c = wave >> 2, qt = wave & 3, r32 = lane & 31, hi = lane >> 5;
    const int q0 = qb * 128, t = q0 + 32 * qt + r32;
    const bf16* P = (const bf16*)(a.ws + WS_PROJ) + (size_t)b * SEQ * LDP;
    bf16* MIX = (bf16*)(a.ws + WS_MIX) + (size_t)b * SEQ * DM;
    bf16x8 qf[4];
    { const bf16* qrow = P + (size_t)t * LDP + C_DQ + h * 128 + c * 64;
#pragma unroll
      for (int s = 0; s < 4; ++s) qf[s] = *(const bf16x8*)(qrow + 16 * s + 8 * hi); }
    float qn;
    { float q2 = 0.f;
#pragma unroll
      for (int s = 0; s < 4; ++s) { const v4u w = __builtin_bit_cast(v4u, qf[s]);
#pragma unroll
          for (int k = 0; k < 4; ++k) q2 += bflo(w[k]) * bflo(w[k]) + bfhi(w[k]) * bfhi(w[k]); }
      q2 = swap32_sum(q2);
      q2 = fmaxf(q2, DPP_X1(q2)); q2 = fmaxf(q2, DPP_X2(q2)); q2 = fmaxf(q2, DPP_HM(q2)); q2 = fmaxf(q2, DPP_RM(q2)); q2 = fmaxf(q2, SWZ_XORF(q2, 16));
      qn = sqrtf(q2) * 1.001f; }
    const float s8 = 8.f * exp2f(-2.f * (float)(h + 1));
    typedef float f32x2p __attribute__((ext_vector_type(2)));
    f32x16 CR;
#pragma unroll
    for (int r = 0; r < 16; ++r) CR[r] = s8 * (float)crow(r, hi);
    const float base_l = -s8 * (float)t;
    constexpr float c1 = 0.125f * 1.4426950408889634f;
    f32x16 O[4];
#pragma unroll
    for (int e = 0; e < 4; ++e)
#pragma unroll
        for (int r = 0; r < 16; ++r) O[e][r] = 0.f;
    float m = -1e30f, lsum = 0.f;
    float mfloor = -1e30f; int nproc = 0;
    const int NT = 2 * qb + 2;
    constexpr int KROW = 144, VROW = 64, VTILE = 64 * VROW, KBYTES = 64 * KROW, VOFF = 2 * KBYTES, BUFB = VOFF + 4 * VTILE;
    v4u pre[4], pre2[4];
    const bf16* gsrc[4]; int ldst[4];
#pragma unroll
    for (int i = 0; i < 4; ++i) { const int idx = tid + 512 * i;
        if (i < 2) { const int cc = idx >> 9, key = (idx >> 3) & 63, ch = idx & 7; gsrc[i] = P + (size_t)key * LDP + C_DK + h * 128 + cc * 64 + ch * 8; ldst[i] = cc * KBYTES + key * KROW + ch * 16; }
        else { const int j = idx - 1024, key = j >> 4, ch = j & 15; gsrc[i] = P + (size_t)key * LDP + C_DV + h * 128 + ch * 8; ldst[i] = VOFF + (ch >> 2) * VTILE + key * VROW + (ch & 3) * 16; } }
#define DIFF_LOAD(dst, kt) do { _Pragma("unroll") for (int i = 0; i < 4; ++i) dst[i] = *(const v4u*)(gsrc[i] + (size_t)(kt) * 64 * LDP); } while (0)
#define DIFF_WRITE(pre, buf) do { _Pragma("unroll") for (int i = 0; i < 4; ++i) *(LAS v4u*)(lds + (buf) * BUFB + ldst[i]) = pre[i]; \
        if (h < 2) _Pragma("unroll") for (int i = 0; i < 2; ++i) { float k2 = 0.f; _Pragma("unroll") for (int k = 0; k < 4; ++k) k2 += bflo(pre[i][k]) * bflo(pre[i][k]) + bfhi(pre[i][k]) * bfhi(pre[i][k]); \
            k2 += DPP_X1(k2); k2 += DPP_X2(k2); k2 += DPP_HM(k2); k2 = fmaxf(k2, DPP_RM(k2)); \
            if ((lane & 15) == 0) KN2[((buf) * 2 + i) * 32 + wave * 4 + (lane >> 4)] = k2; } } while (0)
    LAS float* KN2 = (LAS float*)(lds + 2 * BUFB);
    volatile LAS int* EX = (volatile LAS int*)(lds + 2 * BUFB + 512);
    if (h < 2 && tid == 0) { unsigned* knf = (unsigned*)(a.ws + WS_CTL) + CW_KNF + (size_t)(l * 16 + b * 2 + h) * 64; unsigned sp = 0;
        while (__hip_atomic_load(knf, __ATOMIC_RELAXED, __HIP_MEMORY_SCOPE_AGENT) == 0u) { __builtin_amdgcn_s_sleep(2); if (++sp > (1u << 22)) break; }
        __builtin_amdgcn_fence(__ATOMIC_ACQUIRE, "agent"); asm volatile("s_waitcnt vmcnt(0)" ::: "memory"); }
    const int kfoff = c * KBYTES + r32 * KROW + 16 * hi;
    const int vfoff = VOFF + (4 * hi + ((lane & 15) >> 2)) * VROW + (16 * ((lane >> 4) & 1) + 4 * (lane & 3)) * 2;
    DIFF_LOAD(pre, NT - 1); DIFF_WRITE(pre, 0);
    DIFF_LOAD(pre, NT - 2);
    __syncthreads();
    float knb = 0.f;
    if (h < 2) knb = sqrtf(__builtin_bit_cast(float, __hip_atomic_load((unsigned*)(a.ws + WS_CTL) + CW_KN + (size_t)((l * 16 + b * 2 + h) * 2 + c) * 16, __ATOMIC_RELAXED, __HIP_MEMORY_SCOPE_AGENT))) * 1.001f;
    int buf = 0;
    for (int kt2 = NT - 1; kt2 >= 1; kt2 -= 2) {
#pragma unroll
    for (int par = 0; par < 2; ++par) { const int kt = kt2 - par;
        if (kt > 1) { if (par == 0) DIFF_LOAD(pre2, kt - 2); else DIFF_LOAD(pre, kt - 2); }
        const int kbase = kt * 64;
        bool live = kbase <= q0 + 32 * qt + 31;
        { const int dmin = (q0 + 32 * qt) - (kbase + 63);
          if (h < 2 && dmin > 0 && nproc >= 2) {
              const LAS f32x4* kp = (const LAS f32x4*)(KN2 + (buf * 2 + c) * 32); f32x4 k4 = kp[0];
#pragma unroll
              for (int w8 = 1; w8 < 8; ++w8) { const f32x4 t4 = kp[w8]; k4.x = fmaxf(k4.x, t4.x); k4.y = fmaxf(k4.y, t4.y); k4.z = fmaxf(k4.z, t4.z); k4.w = fmaxf(k4.w, t4.w); }
              const float kn2 = fmaxf(fmaxf(k4.x, k4.y), fmaxf(k4.z, k4.w));
              const float ub = qn * sqrtf(kn2) * 1.001f - s8 * (float)dmin;
              if ((ub - mfloor) * c1 < -40.f) live = false; } }
        if (live) {
            lds_cptr kb = (lds_cptr)(lds + buf * BUFB + kfoff); lds_cptr vb = (lds_cptr)(lds + buf * BUFB + vfoff);
            f32x16 S0, S1;
            bf16x8 kf[8];
#pragma unroll
            for (int s = 0; s < 4; ++s) { kf[2 * s] = *(const LAS bf16x8*)(kb + 32 * s); kf[2 * s + 1] = *(const LAS bf16x8*)(kb + 32 * KROW + 32 * s); }
            const float off0 = s8 * (float)kbase + base_l, off1 = off0 + s8 * 32.f;
            __builtin_amdgcn_sched_barrier(0);
            S0 = MFMA32(kf[0], qf[0], CR); S1 = MFMA32(kf[1], qf[0], CR);
#pragma unroll
            for (int s = 1; s < 4; ++s) { S0 = MFMA32(kf[2 * s], qf[s], S0); S1 = MFMA32(kf[2 * s + 1], qf[s], S1); }
            asm volatile("s_nop 15\n\ts_nop 7" : "+v"(S0), "+v"(S1));
            if (kt >= NT - 2) {
#pragma unroll
                for (int r = 0; r < 16; ++r) { const int key = kbase + crow(r, hi); if (key > t) S0[r] = -1e30f; if (key + 32 > t) S1[r] = -1e30f; } }
            float mt0 = max2a(S0[0], S0[1]), mt1 = max2a(S1[0], S1[1]);
#pragma unroll
            for (int r = 2; r < 16; r += 2) { mt0 = max3a(mt0, S0[r], S0[r + 1]); mt1 = max3a(mt1, S1[r], S1[r + 1]); }
            float mt = fmaxf(mt0 + off0, mt1 + off1);
            mt = swap32_max(mt);
            if (!__all((mt - m) * c1 < -40.f)) {
            const float mn = max2a(m, mt);
            if (__any(mn > m)) { const float al = __builtin_amdgcn_exp2f((m - mn) * c1); lsum *= al;
#pragma unroll
                for (int e = 0; e < 4; ++e)
#pragma unroll
                    for (int r = 0; r < 16; ++r) O[e][r] *= al;
                m = mn; }
            const float mc0 = (off0 - m) * c1, mc1 = (off1 - m) * c1; const f32x2p c1v = (f32x2p){c1, c1}, mcv0 = (f32x2p){mc0, mc0}, mcv1 = (f32x2p){mc1, mc1}; f32x2p psv = (f32x2p){0.f, 0.f};
#pragma unroll
            for (int i = 0; i < 8; ++i) { f32x2p a0 = (f32x2p){S0[2 * i], S0[2 * i + 1]} * c1v + mcv0, a1 = (f32x2p){S1[2 * i], S1[2 * i + 1]} * c1v + mcv1;
                a0.x = __builtin_amdgcn_exp2f(a0.x); a0.y = __builtin_amdgcn_exp2f(a0.y); a1.x = __builtin_amdgcn_exp2f(a1.x); a1.y = __builtin_amdgcn_exp2f(a1.y);
                S0[2 * i] = a0.x; S0[2 * i + 1] = a0.y; S1[2 * i] = a1.x; S1[2 * i + 1] = a1.y; psv += a0 + a1; }
            lsum += psv.x + psv.y;
            bf16x8 pf[4]; pf[0] = pack8(S0, 0); pf[1] = pack8(S0, 1); pf[2] = pack8(S1, 0); pf[3] = pack8(S1, 1);
#pragma unroll
            for (int k16 = 0; k16 < 4; ++k16)
#pragma unroll
                for (int e = 0; e < 4; ++e) { const bf16x8 vf = tr_frag(vb + 16 * k16 * VROW + e * VTILE, 8 * VROW); O[e] = MFMA32(vf, pf[k16], O[e]); }
            }
            ++nproc;
            if (nproc == 2 || nproc == 6) { float mm = swap32_min(m); mm = fminf(mm, DPP_X1(mm)); mm = fminf(mm, DPP_X2(mm)); mm = fminf(mm, DPP_HM(mm)); mm = fminf(mm, DPP_RM(mm)); mm = fminf(mm, SWZ_XORF(mm, 16)); mfloor = mm; }
        }
        if (kt > 0) { if (par == 0) DIFF_WRITE(pre, buf ^ 1); else DIFF_WRITE(pre2, buf ^ 1); }
        if (h < 2 && kt > 0) {
            const int dminn = (q0 + 32 * qt) - ((kt - 1) * 64 + 63);
            const bool dn = nproc >= 2 && dminn > 0 && ((qn * knb - s8 * (float)dminn - mfloor) * c1 < -40.f);
            if (lane == 0) EX[(kt & 1) * 8 + wave] = dn ? 1 : 0; }
        __syncthreads();
        buf ^= 1;
        if (h < 2 && kt > 0) { int alld = 1;
#pragma unroll
            for (int w8 = 0; w8 < 8; ++w8) alld &= EX[(kt & 1) * 8 + w8];
            if (alld) goto diff_done; }
    } }
diff_done:
#undef DIFF_LOAD
#undef DIFF_WRITE
    lsum = swap32_sum(lsum);
    const float il = 1.f / lsum;
    LAS float* X = (LAS float*)lds;
    if (c == 1) {
#pragma unroll
        for (int e = 0; e < 4; ++e)
#pragma unroll
            for (int r = 0; r < 16; ++r) X[(qt * 64 + e * 16 + r) * 64 + lane] = O[e][r] * il; }
    __syncthreads();
    if (c == 0) {
        float ss = 0.f;
#pragma unroll
        for (int e = 0; e < 4; ++e)
#pragma unroll
            for (int r = 0; r < 16; ++r) { const float v = O[e][r] * il - lam * X[(qt * 64 + e * 16 + r) * 64 + lane]; O[e][r] = v; ss += v * v; }
        ss += __shfl_xor(ss, 32);
        const float rn = (1.f - lam_init) / sqrtf(ss * (1.f / 128.f) + NORM_EPS);
        const float* gain = a.in[11] + l * 128;
        bf16* orow = MIX + (size_t)t * DM + 1024 + h * 128;
#pragma unroll
        for (int e = 0; e < 4; ++e)
#pragma unroll
            for (int rg = 0; rg < 4; ++rg) { const int e0 = 32 * e + 8 * rg + 4 * hi; const f32x4 g = *(const f32x4*)(gain + e0);
                v2u w; w.x = cvtpk(O[e][4 * rg + 0] * rn * g.x, O[e][4 * rg + 1] * rn * g.y); w.y = cvtpk(O[e][4 * rg + 2] * rn * g.z, O[e][4 * rg + 3] * rn * g.w);
                *(v2u*)(orow + e0) = w; }
    }
}


#define SWZ_XOR(v, k) __builtin_bit_cast(float, __builtin_amdgcn_ds_swizzle(__builtin_bit_cast(int, (float)(v)), ((k) << 10) | 0x1f))
__device__ __forceinline__ float bperm_f(int src_lane, float v) { return __builtin_bit_cast(float, __builtin_amdgcn_ds_bpermute(src_lane << 2, __builtin_bit_cast(int, v))); }
__device__ __forceinline__ float silu_fast(float x) { return x * __builtin_amdgcn_rcpf(1.0f + __builtin_amdgcn_exp2f(-1.4426950408889634f * x)); }
__device__ __forceinline__ float exp_fast(float x) { return __builtin_amdgcn_exp2f(1.4426950408889634f * x); }
template <int MODE>
__device__ __forceinline__ void ssd_unit_mfma(const Args& a, int l, int b, int g, int seg, LAS unsigned char* lds, int tid) {
    asm volatile("" : "+v"(tid));
    constexpr int CH = 64, BROW = 272, XROW = 528;
    constexpr int OFF_B = 0, OFF_C = OFF_B + CH * BROW, OFF_X = OFF_C + CH * BROW, OFF_Y = OFF_X + CH * XROW, OFF_T = OFF_Y + CH * XROW, OFF_W = OFF_T + 3072;
    const int wave = __builtin_amdgcn_readfirstlane(tid >> 6);
    const int hr = wave >> 1, pt = wave & 1;
    LAS float* dtT = (LAS float*)(lds + OFF_T); LAS float* acT = dtT + CH * 4; LAS float* wT = acT + CH * 4;
    const bf16* P = (const bf16*)(a.ws + WS_PROJ) + (size_t)b * SEQ * LDP;
    bf16* MIX = (bf16*)(a.ws + WS_MIX) + (size_t)b * SEQ * DM;
    { const int c = tid; const int cc = c < 256 ? g * 256 + c : (c < 384 ? 512 + g * 128 + (c - 256) : 768 + g * 128 + (c - 384));
      const f32x4 w = *(const f32x4*)(a.in[4] + (size_t)l * 4096 + cc * 4); const float bb = a.in[5][l * 1024 + cc];
      *(LAS f32x4*)(lds + OFF_W + c * 32) = w; *(LAS float*)(lds + OFF_W + c * 32 + 16) = bb; }
    const float* dtb = a.in[6] + l * 8 + g * 4; const float* alog = a.in[7] + l * 8 + g * 4; const float* dsk = a.in[8] + l * 8 + g * 4;
    const float* ngain = a.in[9] + l * 512 + g * 256;
    f32x16 H[4];
#pragma unroll
    for (int n = 0; n < 4; ++n)
#pragma unroll
        for (int r = 0; r < 16; ++r) H[n][r] = 0.f;
    constexpr int SEGT = 512;
    const int tbeg = seg * SEGT, tend = tbeg + SEGT;
    const int unit16 = b * 2 + g;
    float* SL = (float*)((unsigned char*)a.out + OS_SSDS); float* SD = (float*)((unsigned char*)a.out + OS_SSDL); unsigned* flags = (unsigned*)(a.ws + WS_CTL) + CW_FLAG + (size_t)((l * 16 + unit16) * 8) * 64;
    float lsum = 0.f;
    v4u raw[11]; float dtraw = 0.f;
#define SSD_PREFETCH(t0n) do { int tl_ = tid; asm volatile("" : "+v"(tl_)); const int cg_ = tl_ & 63; \
        const int col_ = C_SXBC + (cg_ < 32 ? g * 256 + 8 * cg_ : (cg_ < 48 ? 512 + g * 128 + 8 * (cg_ - 32) : 768 + g * 128 + 8 * (cg_ - 48))); \
        _Pragma("unroll") for (int i_ = 0; i_ < 11; ++i_) { const int row_ = (t0n) + 8 * wave - 3 + i_; \
            raw[i_] = (row_ >= 0) ? *(const v4u*)(P + (size_t)row_ * LDP + col_) : (v4u){0u, 0u, 0u, 0u}; } \
        if (wave < 4) dtraw = ((const float*)(a.ws + WS_DT))[((size_t)b * SEQ + (t0n) + cg_) * 8 + g * 4 + wave]; } while (0)
    SSD_PREFETCH(tbeg);
    if (MODE == 1 && seg > 0) {
        if (tid == 0) { for (int j = 0; j < seg; ++j) { unsigned sp = 0; while (__hip_atomic_load(flags + j * 64, __ATOMIC_RELAXED, __HIP_MEMORY_SCOPE_AGENT) == 0u) { __builtin_amdgcn_s_sleep(2); if (++sp > (1u << 22)) break; } }
            __builtin_amdgcn_fence(__ATOMIC_ACQUIRE, "agent"); asm volatile("s_waitcnt vmcnt(0)" ::: "memory"); }
        __syncthreads();
        { int tl = tid; asm volatile("" : "+v"(tl)); const int lane = tl & 63;
          float cum = 0.f;
          for (int j = seg - 1; j >= 0; --j) { const float f = exp_fast(cum);
              const float* src = SL + ((size_t)((unit16 * 8 + j) * 8 + wave) * 16) * 256 + lane * 4;
#pragma unroll
              for (int n = 0; n < 4; ++n)
#pragma unroll
                  for (int rq = 0; rq < 4; ++rq) { const f32x4 v = *(const f32x4*)(src + (n * 4 + rq) * 256);
                      H[n][4 * rq + 0] += f * v.x; H[n][4 * rq + 1] += f * v.y; H[n][4 * rq + 2] += f * v.z; H[n][4 * rq + 3] += f * v.w; }
              cum += SD[(unit16 * 8 + j) * 4 + hr]; } }
    }
    __syncthreads();
    for (int t0 = tbeg; t0 < tend; t0 += CH) {
        { int tl = tid; asm volatile("" : "+v"(tl)); const int cg = tl & 63, lane = cg;
          const int dst = (cg < 32 ? OFF_X + cg * 16 : (cg < 48 ? OFF_B + (cg - 32) * 16 : OFF_C + (cg - 48) * 16));
          const int dstride = cg < 32 ? XROW : BROW;
#pragma unroll
          for (int hf = 0; hf < 2; ++hf) {
              f32x4 wv[4]; float bv[4];
#pragma unroll
              for (int c = 0; c < 4; ++c) { wv[c] = *(const LAS f32x4*)(lds + OFF_W + (8 * cg + 4 * hf + c) * 32); bv[c] = *(const LAS float*)(lds + OFF_W + (8 * cg + 4 * hf + c) * 32 + 16); }
              float xw[4][4];
#pragma unroll
              for (int k = 0; k < 3; ++k)
#pragma unroll
                  for (int j = 0; j < 2; ++j) { xw[k][2 * j] = bflo(raw[k][2 * hf + j]); xw[k][2 * j + 1] = bfhi(raw[k][2 * hf + j]); }
#pragma unroll
              for (int i = 0; i < 8; ++i) {
#pragma unroll
                  for (int j = 0; j < 2; ++j) { xw[(i + 3) & 3][2 * j] = bflo(raw[i + 3][2 * hf + j]); xw[(i + 3) & 3][2 * j + 1] = bfhi(raw[i + 3][2 * hf + j]); }
                  float o[4];
#pragma unroll
                  for (int c = 0; c < 4; ++c) { const float cv = bv[c] + wv[c].x * xw[i & 3][c] + wv[c].y * xw[(i + 1) & 3][c] + wv[c].z * xw[(i + 2) & 3][c] + wv[c].w * xw[(i + 3) & 3][c]; o[c] = silu_fast(cv); }
                  v2u w; w.x = cvtpk(o[0], o[1]); w.y = cvtpk(o[2], o[3]);
                  *(LAS v2u*)(lds + dst + 8 * hf + (8 * wave + i) * dstride) = w;
                  __builtin_amdgcn_sched_barrier(0); }
              asm volatile("" ::: "memory");
          }
          if (wave < 4) { const int r = wave;
              const float xv = dtraw + dtb[r];
              const float dtv = xv > 20.f ? xv : log1pf(__expf(xv));
              float ac = dtv * (-__expf(alog[r]));
#pragma unroll
              for (int off = 1; off < 64; off <<= 1) { const float o = bperm_f(lane - off, ac); if (lane >= off) ac += o; }
              const float tot = bperm_f(63, ac);
              lsum += tot;
              dtT[lane * 4 + r] = dtv; acT[lane * 4 + r] = ac; wT[lane * 4 + r] = dtv * exp_fast(tot - ac); } }
        if (MODE == 0 && t0 + CH < tend) SSD_PREFETCH(t0 + CH);
        __syncthreads();
        v4u zr[4];
        if (MODE == 1) { int tl = tid; asm volatile("" : "+v"(tl)); const int tt = tl >> 3, c0 = (tl & 7) * 32;
#pragma unroll
          for (int i = 0; i < 4; ++i) zr[i] = *(const v4u*)(P + (size_t)(t0 + tt) * LDP + C_SZ + g * 256 + c0 + 8 * i); }
        {
            int tl = tid; asm volatile("" : "+v"(tl)); const int lane = tl & 63, r32 = lane & 31, hi = lane >> 5, trq = (lane & 15) >> 2;
            const int chcol = (hr * 64 + pt * 32 + 16 * ((lane >> 4) & 1) + 4 * (lane & 3)) * 2;
            lds_cptr Bi = (lds_cptr)(lds + OFF_B), Ci = (lds_cptr)(lds + OFF_C), Xi = (lds_cptr)(lds + OFF_X);
            f32x16 Y[2];
            if (MODE == 1) {
#pragma unroll
            for (int li = 0; li < 2; ++li) {
                f32x16 acc;
#pragma unroll
                for (int r = 0; r < 16; ++r) acc[r] = 0.f;
#pragma unroll
                for (int n = 0; n < 4; ++n)
#pragma unroll
                    for (int s = 0; s < 2; ++s) { lds_cptr cp = Ci + (32 * li + r32) * BROW + (32 * n + 16 * s + 4 * hi) * 2;
                        const s16x4 lo = *(const LAS s16x4*)cp, h4 = *(const LAS s16x4*)(cp + 16);
                        const bf16x8 af = (bf16x8){lo[0], lo[1], lo[2], lo[3], h4[0], h4[1], h4[2], h4[3]};
                        acc = MFMA32(af, pack8(H[n], s), acc); }
#pragma unroll
                for (int r = 0; r < 16; ++r) Y[li][r] = acc[r] * exp_fast(acT[(32 * li + crow(r, hi)) * 4 + hr]);
                __builtin_amdgcn_sched_barrier(0);
            }
#pragma unroll
            for (int tix = 0; tix < 3; ++tix) { const int sj = tix >> 1, li = (tix + 1) >> 1;
                f32x16 cb;
#pragma unroll
                for (int r = 0; r < 16; ++r) cb[r] = 0.f;
#pragma unroll
                for (int kn = 0; kn < 8; ++kn) { const bf16x8 af = *(const LAS bf16x8*)(Bi + (32 * sj + r32) * BROW + (16 * kn + 8 * hi) * 2);
                    const bf16x8 bfr = *(const LAS bf16x8*)(Ci + (32 * li + r32) * BROW + (16 * kn + 8 * hi) * 2);
                    cb = MFMA32(af, bfr, cb); }
                const int lq = 32 * li + r32; const float acl = acT[lq * 4 + hr];
#pragma unroll
                for (int r = 0; r < 16; ++r) { const int sk = 32 * sj + crow(r, hi);
                    const float d = exp_fast(fminf(acl - acT[sk * 4 + hr], 0.f)) * dtT[sk * 4 + hr];
                    cb[r] = (sk <= lq) ? cb[r] * d : 0.f; }
#pragma unroll
                for (int ks = 0; ks < 2; ++ks) { const bf16x8 pa = pack8(cb, ks);
                    const bf16x8 xb = tr_frag(Xi + (32 * sj + 16 * ks + 4 * hi + trq) * XROW + chcol, 8 * XROW);
                    Y[li] = MFMA32(pa, xb, Y[li]); }
                __builtin_amdgcn_sched_barrier(0);
            }
#pragma unroll
            for (int li = 0; li < 2; ++li)
#pragma unroll
                for (int r = 0; r < 16; ++r) *(LAS bf16*)(lds + OFF_Y + (32 * li + crow(r, hi)) * XROW + (hr * 64 + pt * 32 + r32) * 2) = (bf16)cvtpk1(Y[li][r]);
            }
            { const float dec = exp_fast(acT[63 * 4 + hr]);
#pragma unroll
              for (int n = 0; n < 4; ++n)
#pragma unroll
                  for (int r = 0; r < 16; ++r) H[n][r] *= dec; }
            __builtin_amdgcn_sched_barrier(0);
#pragma unroll
            for (int ks = 0; ks < 4; ++ks) {
                const bf16x8 xr = tr_frag(Xi + (16 * ks + 8 * hi + trq) * XROW + chcol, 4 * XROW);
                const v4u xw = __builtin_bit_cast(v4u, xr); v4u sw;
#pragma unroll
                for (int j = 0; j < 4; ++j) { const float wa = wT[(16 * ks + 8 * hi + 2 * j) * 4 + hr], wb = wT[(16 * ks + 8 * hi + 2 * j + 1) * 4 + hr];
                    sw[j] = cvtpk(bflo(xw[j]) * wa, bfhi(xw[j]) * wb); }
                const bf16x8 xs = __builtin_bit_cast(bf16x8, sw);
#pragma unroll
                for (int n = 0; n < 4; ++n) { const bf16x8 ab = tr_frag(Bi + (16 * ks + 8 * hi + trq) * BROW + (32 * n + 16 * ((lane >> 4) & 1) + 4 * (lane & 3)) * 2, 4 * BROW);
                    H[n] = MFMA32(ab, xs, H[n]); }
                __builtin_amdgcn_sched_barrier(0);
            }
        }
        __syncthreads();
        if (MODE == 1 && t0 + CH < tend) SSD_PREFETCH(t0 + CH);
        if (MODE == 1) { int tl = tid; asm volatile("" : "+v"(tl)); const int tt = tl >> 3, c0 = (tl & 7) * 32; const int t = t0 + tt;
          float y[32]; float ss = 0.f; const float dk = dsk[c0 >> 6];
#pragma unroll
          for (int i = 0; i < 4; ++i) { const v4u yw = *(const LAS v4u*)(lds + OFF_Y + tt * XROW + (c0 + 8 * i) * 2); const v4u xw = *(const LAS v4u*)(lds + OFF_X + tt * XROW + (c0 + 8 * i) * 2);
              const v4u zw = zr[i];
#pragma unroll
              for (int k = 0; k < 4; ++k) { const float ya = (bflo(yw[k]) + bflo(xw[k]) * dk) * silu_fast(bflo(zw[k])), yb = (bfhi(yw[k]) + bfhi(xw[k]) * dk) * silu_fast(bfhi(zw[k]));
                  y[8 * i + 2 * k] = ya; y[8 * i + 2 * k + 1] = yb; ss += ya * ya + yb * yb; } }
          ss += SWZ_XOR(ss, 1); ss += SWZ_XOR(ss, 2); ss += SWZ_XOR(ss, 4);
          const float rn = __builtin_amdgcn_rsqf(ss * (1.f / 256.f) + NORM_EPS);
#pragma unroll
          for (int i = 0; i < 4; ++i) { const f32x4 g0 = *(const f32x4*)(ngain + c0 + 8 * i), g1 = *(const f32x4*)(ngain + c0 + 8 * i + 4);
              v4u w; w.x = cvtpk(y[8 * i + 0] * rn * g0.x, y[8 * i + 1] * rn * g0.y); w.y = cvtpk(y[8 * i + 2] * rn * g0.z, y[8 * i + 3] * rn * g0.w);
              w.z = cvtpk(y[8 * i + 4] * rn * g1.x, y[8 * i + 5] * rn * g1.y); w.w = cvtpk(y[8 * i + 6] * rn * g1.z, y[8 * i + 7] * rn * g1.w);
              *(v4u*)(MIX + (size_t)t * DM + 512 + g * 256 + c0 + 8 * i) = w; } }
        if (MODE == 1) __syncthreads();
    }
#undef SSD_PREFETCH
    if (MODE == 0) {
        { int tl = tid; asm volatile("" : "+v"(tl)); const int lane = tl & 63;
          float* dst = SL + ((size_t)((unit16 * 8 + seg) * 8 + wave) * 16) * 256 + lane * 4;
#pragma unroll
          for (int n = 0; n < 4; ++n)
#pragma unroll
              for (int rq = 0; rq < 4; ++rq) *(f32x4*)(dst + (n * 4 + rq) * 256) = (f32x4){H[n][4 * rq + 0], H[n][4 * rq + 1], H[n][4 * rq + 2], H[n][4 * rq + 3]};
          if (wave < 4 && lane == 0) SD[(unit16 * 8 + seg) * 4 + wave] = lsum; }
        asm volatile("s_waitcnt vmcnt(0)" ::: "memory");
        __syncthreads();
        if (tid == 0) { __builtin_amdgcn_fence(__ATOMIC_RELEASE, "agent"); asm volatile("s_waitcnt vmcnt(0)" ::: "memory");
            __hip_atomic_store(flags + seg * 64, 1u, __ATOMIC_RELAXED, __HIP_MEMORY_SCOPE_AGENT); }
    }
}


template <int MODE>
__device__ __forceinline__ void ret_unit_mfma(const Args& a, int l, int b, int h, int seg, LAS unsigned char* lds, int tid) {
    asm volatile("" : "+v"(tid));
    constexpr int CH = 64, KROW = 144, VROW = 272, SEGT = 512;
    constexpr int OFF_K = 0, OFF_Q = OFF_K + CH * KROW, OFF_V = OFF_Q + CH * KROW, OFF_Y = OFF_V + CH * VROW;
    const int wave = __builtin_amdgcn_readfirstlane(tid >> 6), et = wave & 3, qh = wave >> 2;
    const float gl = log2f(1.f - exp2f(-5.f - (float)h));
    const float g64 = exp2f(64.f * gl);
    const bf16* P = (const bf16*)(a.ws + WS_PROJ) + (size_t)b * SEQ * LDP;
    bf16* MIX = (bf16*)(a.ws + WS_MIX) + (size_t)b * SEQ * DM;
    const float* gain = a.in[3] + l * 512 + h * 128;
    const int tbeg = seg * SEGT, tend = tbeg + SEGT, unit32 = b * 4 + h;
    float* RS = (float*)((unsigned char*)a.out + OS_RETS); unsigned* flags = (unsigned*)(a.ws + WS_CTL) + CW_FLAG2 + (size_t)((l * 32 + unit32) * 8) * 64;
    f32x16 Hs[2];
#pragma unroll
    for (int d = 0; d < 2; ++d)
#pragma unroll
        for (int r = 0; r < 16; ++r) Hs[d][r] = 0.f;
    v4u pre[4];
#define RET_PREFETCH(t0n) do { int tl_ = tid; asm volatile("" : "+v"(tl_)); \
        pre[0] = *(const v4u*)(P + (size_t)((t0n) + (tl_ >> 3)) * LDP + C_RK + h * 64 + (tl_ & 7) * 8); \
        if (MODE == 1) pre[1] = *(const v4u*)(P + (size_t)((t0n) + (tl_ >> 3)) * LDP + C_RQ + h * 64 + (tl_ & 7) * 8); \
        pre[2] = *(const v4u*)(P + (size_t)((t0n) + (tl_ >> 4)) * LDP + C_RV + h * 128 + (tl_ & 15) * 8); \
        pre[3] = *(const v4u*)(P + (size_t)((t0n) + 32 + (tl_ >> 4)) * LDP + C_RV + h * 128 + (tl_ & 15) * 8); } while (0)
    RET_PREFETCH(tbeg);
    if (MODE == 1 && seg > 0) {
        if (tid == 0) { for (int j = 0; j < seg; ++j) { unsigned sp = 0; while (__hip_atomic_load(flags + j * 64, __ATOMIC_RELAXED, __HIP_MEMORY_SCOPE_AGENT) == 0u) { __builtin_amdgcn_s_sleep(2); if (++sp > (1u << 22)) break; } }
            __builtin_amdgcn_fence(__ATOMIC_ACQUIRE, "agent"); asm volatile("s_waitcnt vmcnt(0)" ::: "memory"); }
        __syncthreads();
        { int tl = tid; asm volatile("" : "+v"(tl)); const int lane = tl & 63;
          for (int j = 0; j < seg; ++j) { const float f = exp2f(gl * (float)(SEGT * (seg - 1 - j)));
              const float* src = RS + ((size_t)((unit32 * 8 + j) * 4 + et) * 8) * 256 + lane * 4;
#pragma unroll
              for (int d = 0; d < 2; ++d)
#pragma unroll
                  for (int rq = 0; rq < 4; ++rq) { const f32x4 v = *(const f32x4*)(src + (d * 4 + rq) * 256);
                      Hs[d][4 * rq + 0] += f * v.x; Hs[d][4 * rq + 1] += f * v.y; Hs[d][4 * rq + 2] += f * v.z; Hs[d][4 * rq + 3] += f * v.w; } } }
    }
    for (int t0 = tbeg; t0 < tend; t0 += CH) {
        { int tl = tid; asm volatile("" : "+v"(tl));
          { const int row = tl >> 3, ch = tl & 7; const v4u w = pre[0]; const float f = 0.125f * __builtin_amdgcn_exp2f(-gl * (float)row);
            v4u o; o.x = cvtpk(bflo(w.x) * f, bfhi(w.x) * f); o.y = cvtpk(bflo(w.y) * f, bfhi(w.y) * f); o.z = cvtpk(bflo(w.z) * f, bfhi(w.z) * f); o.w = cvtpk(bflo(w.w) * f, bfhi(w.w) * f);
            *(LAS v4u*)(lds + OFF_K + row * KROW + ch * 16) = o;
            if (MODE == 1) *(LAS v4u*)(lds + OFF_Q + row * KROW + ch * 16) = pre[1]; }
          { const int row = tl >> 4, ch = tl & 15; *(LAS v4u*)(lds + OFF_V + row * VROW + ch * 16) = pre[2]; *(LAS v4u*)(lds + OFF_V + (32 + row) * VROW + ch * 16) = pre[3]; } }
        __syncthreads();
        if (t0 + CH < tend) RET_PREFETCH(t0 + CH);
        v4u gz[2];
        if (MODE == 1) { int tl = tid; asm volatile("" : "+v"(tl)); const int tt = tl >> 3, e0 = (tl & 7) * 16;
            gz[0] = *(const v4u*)(P + (size_t)(t0 + tt) * LDP + C_RG + h * 128 + e0); gz[1] = *(const v4u*)(P + (size_t)(t0 + tt) * LDP + C_RG + h * 128 + e0 + 8); }
        { int tl = tid; asm volatile("" : "+v"(tl)); const int lane = tl & 63, r32 = lane & 31, hi = lane >> 5, trq = (lane & 15) >> 2;
          const int trc = (16 * ((lane >> 4) & 1) + 4 * (lane & 3)) * 2;
          lds_cptr Ki = (lds_cptr)(lds + OFF_K), Qi = (lds_cptr)(lds + OFF_Q), Vi = (lds_cptr)(lds + OFF_V);
          if (MODE == 1) {
          f32x16 Y;
#pragma unroll
          for (int r = 0; r < 16; ++r) Y[r] = 0.f;
#pragma unroll
          for (int d = 0; d < 2; ++d)
#pragma unroll
              for (int s = 0; s < 2; ++s) { lds_cptr qp = Qi + (32 * qh + r32) * KROW + (32 * d + 16 * s + 4 * hi) * 2;
                  const s16x4 lo = *(const LAS s16x4*)qp, h4 = *(const LAS s16x4*)(qp + 16);
                  const bf16x8 af = (bf16x8){lo[0], lo[1], lo[2], lo[3], h4[0], h4[1], h4[2], h4[3]};
                  Y = MFMA32(af, pack8(Hs[d], s), Y); }
#pragma unroll
          for (int r = 0; r < 16; ++r) Y[r] *= g64;
          for (int sj = 0; sj <= qh; ++sj) {
              f32x16 S;
#pragma unroll
              for (int r = 0; r < 16; ++r) S[r] = 0.f;
#pragma unroll
              for (int kd = 0; kd < 4; ++kd) { const bf16x8 af = *(const LAS bf16x8*)(Ki + (32 * sj + r32) * KROW + (16 * kd + 8 * hi) * 2);
                  const bf16x8 bfr = *(const LAS bf16x8*)(Qi + (32 * qh + r32) * KROW + (16 * kd + 8 * hi) * 2);
                  S = MFMA32(af, bfr, S); }
              if (sj == qh) {
#pragma unroll
                  for (int r = 0; r < 16; ++r) if (crow(r, hi) > r32) S[r] = 0.f; }
#pragma unroll
              for (int ks = 0; ks < 2; ++ks) { const bf16x8 vb = tr_frag(Vi + (32 * sj + 16 * ks + 4 * hi + trq) * VROW + 64 * et + trc, 8 * VROW);
                  Y = MFMA32(pack8(S, ks), vb, Y); }
          }
#pragma unroll
          for (int r = 0; r < 16; ++r) { const int lq = 32 * qh + crow(r, hi);
              *(LAS bf16*)(lds + OFF_Y + lq * VROW + (32 * et + r32) * 2) = (bf16)cvtpk1(Y[r] * __builtin_amdgcn_exp2f(gl * (float)lq)); }
          }
#pragma unroll
          for (int d = 0; d < 2; ++d)
#pragma unroll
              for (int r = 0; r < 16; ++r) Hs[d][r] *= g64;
#pragma unroll
          for (int ks = 0; ks < 4; ++ks) { const bf16x8 vb = tr_frag(Vi + (16 * ks + 8 * hi + trq) * VROW + 64 * et + trc, 4 * VROW);
#pragma unroll
              for (int d = 0; d < 2; ++d) { const bf16x8 ka = tr_frag(Ki + (16 * ks + 8 * hi + trq) * KROW + 64 * d + trc, 4 * KROW);
                  Hs[d] = MFMA32(ka, vb, Hs[d]); } }
        }
        __syncthreads();
        if (MODE == 1) { int tl = tid; asm volatile("" : "+v"(tl)); const int tt = tl >> 3, e0 = (tl & 7) * 16; const int t = t0 + tt;
          float y[16]; float ss = 0.f;
#pragma unroll
          for (int i = 0; i < 2; ++i) { const v4u yw = *(const LAS v4u*)(lds + OFF_Y + tt * VROW + (e0 + 8 * i) * 2);
#pragma unroll
              for (int k = 0; k < 4; ++k) { y[8 * i + 2 * k] = bflo(yw[k]); y[8 * i + 2 * k + 1] = bfhi(yw[k]); ss += y[8 * i + 2 * k] * y[8 * i + 2 * k] + y[8 * i + 2 * k + 1] * y[8 * i + 2 * k + 1]; } }
          ss += SWZ_XOR(ss, 1); ss += SWZ_XOR(ss, 2); ss += SWZ_XOR(ss, 4);
          const float rn = __builtin_amdgcn_rsqf(ss * (1.f / 128.f) + NORM_EPS);
#pragma unroll
          for (int i = 0; i < 2; ++i) { const v4u gw = gz[i];
              const f32x4 g0 = *(const f32x4*)(gain + e0 + 8 * i), g1 = *(const f32x4*)(gain + e0 + 8 * i + 4);
              v4u w; w.x = cvtpk(y[8 * i + 0] * rn * g0.x * silu_fast(bflo(gw.x)), y[8 * i + 1] * rn * g0.y * silu_fast(bfhi(gw.x)));
              w.y = cvtpk(y[8 * i + 2] * rn * g0.z * silu_fast(bflo(gw.y)), y[8 * i + 3] * rn * g0.w * silu_fast(bfhi(gw.y)));
              w.z = cvtpk(y[8 * i + 4] * rn * g1.x * silu_fast(bflo(gw.z)), y[8 * i + 5] * rn * g1.y * silu_fast(bfhi(gw.z)));
              w.w = cvtpk(y[8 * i + 6] * rn * g1.z * silu_fast(bflo(gw.w)), y[8 * i + 7] * rn * g1.w * silu_fast(bfhi(gw.w)));
              *(v4u*)(MIX + (size_t)t * DM + h * 128 + e0 + 8 * i) = w; } }
    }
#undef RET_PREFETCH
    if (MODE == 0) {
        if (qh == 0) { int tl = tid; asm volatile("" : "+v"(tl)); const int lane = tl & 63;
          float* dst = RS + ((size_t)((unit32 * 8 + seg) * 4 + et) * 8) * 256 + lane * 4;
#pragma unroll
          for (int d = 0; d < 2; ++d)
#pragma unroll
              for (int rq = 0; rq < 4; ++rq) *(f32x4*)(dst + (d * 4 + rq) * 256) = (f32x4){Hs[d][4 * rq + 0], Hs[d][4 * rq + 1], Hs[d][4 * rq + 2], Hs[d][4 * rq + 3]}; }
        asm volatile("s_waitcnt vmcnt(0)" ::: "memory");
        __syncthreads();
        if (tid == 0) { __builtin_amdgcn_fence(__ATOMIC_RELEASE, "agent"); asm volatile("s_waitcnt vmcnt(0)" ::: "memory");
            __hip_atomic_store(flags + seg * 64, 1u, __ATOMIC_RELAXED, __HIP_MEMORY_SCOPE_AGENT); }
    }
}

template <int DIL>
__device__ __forceinline__ void dil_loadq(bf16x8 (&qn)[4], const bf16* P, int h, int rs, int blk, int tid) {
    int tl = tid; asm volatile("" : "+v"(tl));
    const int lane = tl & 63; const int tq = (256 * blk + 32 * (tl >> 6) + (lane & 31)) * DIL + rs; const bf16* qrow = P + (size_t)((tq & 15) * 256 + (tq >> 4)) * 192;
#pragma unroll
    for (int s = 0; s < 4; ++s) qn[s] = *(const bf16x8*)(qrow + 16 * s + 8 * (lane >> 5));
}
template <int DIL>
__device__ __forceinline__ void dil_load(v4u (&pre)[12], const bf16* P, int h, int rs, int blk, int tid) {
    int tl = tid; asm volatile("" : "+v"(tl));
    const int m0 = 256 * blk - 128;
#pragma unroll
    for (int i = 0; i < 12; ++i) { const int idx = tl + 512 * i; const int which = i >= 6 ? 1 : 0; const int j = idx - which * 3072; const int row = j >> 3, ch = j & 7; const int mk = m0 + row;
        const int tk = mk * DIL + rs;
        pre[i] = (mk >= 0) ? *(const v4u*)(P + (size_t)((tk & 15) * 256 + (tk >> 4)) * 192 + (which ? 128 : 64) + ch * 8) : (v4u){0u, 0u, 0u, 0u}; }
}
__device__ __forceinline__ void dil_write(const v4u (&pre)[12], LAS unsigned char* lds, int tid) {
    constexpr int ROW = 144, IMG = 384 * ROW;
    int tl = tid; asm volatile("" : "+v"(tl));
#pragma unroll
    for (int i = 0; i < 12; ++i) { const int idx = tl + 512 * i; const int which = i >= 6 ? 1 : 0; const int j = idx - which * 3072; const int row = j >> 3, ch = j & 7;
        *(LAS v4u*)(lds + which * IMG + row * ROW + ch * 16) = pre[i]; }
}
template <int DIL>
__device__ __forceinline__ void dil_compute(const Args& a, bf16x8 (&qf)[4], int b, int h, int rs, int blk, int nrs, int nblk, bool has_next, LAS unsigned char* lds, int tid) {
    constexpr int ROW = 144, IMG = 384 * ROW;
    constexpr int PIDX = DIL == 4 ? 0 : 1;
    const bf16* P = (const bf16*)(a.ws + WS_DQKV) + (size_t)(b * 8 + h) * (SEQ * 192);
    bf16* OP = (bf16*)((unsigned char*)a.out + OS_DILO); float* LSE = (float*)((unsigned char*)a.out + OS_DILL);
    const int m0 = 256 * blk - 128;
    { int tl = tid; asm volatile("" : "+v"(tl)); const int lane = tl & 63, r32 = lane & 31, hi = lane >> 5, trq = (lane & 15) >> 2;
      const int w = __builtin_amdgcn_readfirstlane(tl >> 6);
      const int trc = (16 * ((lane >> 4) & 1) + 4 * (lane & 3)) * 2;
      const int mq = 256 * blk + 32 * w + r32; const int tq = mq * DIL + rs;
      lds_cptr Ki = (lds_cptr)lds, Vi = (lds_cptr)(lds + IMG);
      const size_t grow = (size_t)b * SEQ + tq;
      constexpr float c1 = 0.125f * 1.4426950408889634f;
      const float sl2 = exp2f(-(float)(h + 1)) * (float)DIL * 1.4426950408889634f;
      f32x16 CRS;
#pragma unroll
      for (int r = 0; r < 16; ++r) CRS[r] = (sl2 * (1.f / c1)) * (float)crow(r, hi);
      f32x16 S[5];
#pragma unroll
      for (int j = 0; j < 5; ++j) {
#pragma unroll
          for (int s = 0; s < 4; ++s) { const bf16x8 kf = *(const LAS bf16x8*)(Ki + (32 * w + 32 * j + r32) * ROW + (16 * s + 8 * hi) * 2); S[j] = MFMA32(kf, qf[s], s == 0 ? CRS : S[j]); } }
      __builtin_amdgcn_sched_barrier(0);
      if (has_next) dil_loadq<DIL>(qf, P, h, nrs, nblk, tid);
#pragma unroll
      for (int r = 0; r < 16; ++r) { if (crow(r, hi) < r32) S[0][r] = -1e30f; if (crow(r, hi) > r32) S[4][r] = -1e30f; }
      if (blk == 0) {
#pragma unroll
          for (int j = 0; j < 4; ++j)
#pragma unroll
              for (int r = 0; r < 16; ++r) if (32 * w + 32 * j + crow(r, hi) < 128) S[j][r] = -1e30f; }
      float bjs[5]; float mt = -1e30f;
#pragma unroll
      for (int j = 0; j < 5; ++j) { bjs[j] = -sl2 * (float)(128 + r32 - 32 * j); float mj = S[j][0];
#pragma unroll
          for (int r = 1; r < 16; ++r) mj = fmaxf(mj, S[j][r]);
          mt = fmaxf(mt, mj * c1 + bjs[j]); }
      mt = swap32_max(mt);
      float ls = 0.f;
#pragma unroll
      for (int j = 0; j < 5; ++j) { const float aj = bjs[j] - mt;
#pragma unroll
          for (int r = 0; r < 16; ++r) { const float p = __builtin_amdgcn_exp2f(S[j][r] * c1 + aj); S[j][r] = p; ls += p; } }
      ls = swap32_sum(ls);
      float l1 = 0.f, l2 = 0.f; v2u a1[8], a2[8];
      if (DIL == 1) { l1 = LSE[((size_t)0 * M + grow) * 8 + h]; l2 = LSE[((size_t)1 * M + grow) * 8 + h];
          const bf16* o1 = OP + ((size_t)0 * M + grow) * 512 + h * 64; const bf16* o2 = OP + ((size_t)1 * M + grow) * 512 + h * 64;
#pragma unroll
          for (int d = 0; d < 2; ++d)
#pragma unroll
              for (int rg = 0; rg < 4; ++rg) { const int d0 = 32 * d + 8 * rg + 4 * hi; a1[d * 4 + rg] = *(const v2u*)(o1 + d0); a2[d * 4 + rg] = *(const v2u*)(o2 + d0); } }
      f32x16 O[2];
#pragma unroll
      for (int d = 0; d < 2; ++d)
#pragma unroll
          for (int r = 0; r < 16; ++r) O[d][r] = 0.f;
#pragma unroll
      for (int j = 0; j < 5; ++j)
#pragma unroll
          for (int ks = 0; ks < 2; ++ks) { const bf16x8 pf = pack8(S[j], ks);
#pragma unroll
              for (int d = 0; d < 2; ++d) { const bf16x8 vf = tr_frag(Vi + (32 * w + 32 * j + 16 * ks + 4 * hi + trq) * ROW + 64 * d + trc, 8 * ROW); O[d] = MFMA32(vf, pf, O[d]); } }
      const float il = 1.f / ls; const float lse2 = mt + __builtin_amdgcn_logf(ls);
      if (DIL != 1) {
          bf16* orow = OP + ((size_t)PIDX * M + grow) * 512 + h * 64;
#pragma unroll
          for (int d = 0; d < 2; ++d)
#pragma unroll
              for (int rg = 0; rg < 4; ++rg) { v2u wv; wv.x = cvtpk(O[d][4 * rg] * il, O[d][4 * rg + 1] * il); wv.y = cvtpk(O[d][4 * rg + 2] * il, O[d][4 * rg + 3] * il);
                  *(v2u*)(orow + 32 * d + 8 * rg + 4 * hi) = wv; }
          if (hi == 0) LSE[((size_t)PIDX * M + grow) * 8 + h] = lse2;
      } else {
          const float mm = fmaxf(lse2, fmaxf(l1, l2));
          const float w0 = __builtin_amdgcn_exp2f(lse2 - mm), w1 = __builtin_amdgcn_exp2f(l1 - mm), w2 = __builtin_amdgcn_exp2f(l2 - mm);
          const float iw = 1.f / (w0 + w1 + w2);
          const float f0 = w0 * iw * il, f1 = w1 * iw, f2 = w2 * iw;
          bf16* mrow = (bf16*)(a.ws + WS_MIX) + grow * DM + 1536 + h * 64;
#pragma unroll
          for (int d = 0; d < 2; ++d)
#pragma unroll
              for (int rg = 0; rg < 4; ++rg) { const int d0 = 32 * d + 8 * rg + 4 * hi; const v2u p1 = a1[d * 4 + rg], p2 = a2[d * 4 + rg];
                  v2u wv; wv.x = cvtpk(O[d][4 * rg] * f0 + bflo(p1.x) * f1 + bflo(p2.x) * f2, O[d][4 * rg + 1] * f0 + bfhi(p1.x) * f1 + bfhi(p2.x) * f2);
                  wv.y = cvtpk(O[d][4 * rg + 2] * f0 + bflo(p1.y) * f1 + bflo(p2.y) * f2, O[d][4 * rg + 3] * f0 + bfhi(p1.y) * f1 + bfhi(p2.y) * f2);
                  *(v2u*)(mrow + d0) = wv; }
      }
    }
}
template <int DIL>
__device__ __forceinline__ void dil_unit_mfma(const Args& a, int l, int b, int h, int part, LAS unsigned char* lds, int tid) {
    asm volatile("" : "+v"(tid));
    const bf16* P = (const bf16*)(a.ws + WS_DQKV) + (size_t)(b * 8 + h) * (SEQ * 192);
    unsigned* flags = (unsigned*)(a.ws + WS_CTL) + CW_FLAG3 + (size_t)((l * 64 + b * 8 + h) * 4) * 64;
    const int i0 = (part & 1) * 8;
#define DIL_RS(i) (DIL == 16 ? (i) : (DIL == 4 ? ((i) & 3) : 0))
#define DIL_BLK(i) (DIL == 16 ? 0 : (DIL == 4 ? ((i) >> 2) : (i)))
    v4u pre[12]; bf16x8 qf[4];
    dil_load<DIL>(pre, P, h, DIL_RS(i0), DIL_BLK(i0), tid);
    dil_loadq<DIL>(qf, P, h, DIL_RS(i0), DIL_BLK(i0), tid);
    if (DIL == 1) {
        if (tid == 0) { for (int j = 0; j < 4; ++j) { unsigned sp = 0; while (__hip_atomic_load(flags + j * 64, __ATOMIC_RELAXED, __HIP_MEMORY_SCOPE_AGENT) == 0u) { __builtin_amdgcn_s_sleep(2); if (++sp > (1u << 22)) break; } }
            __builtin_amdgcn_fence(__ATOMIC_ACQUIRE, "agent"); asm volatile("s_waitcnt vmcnt(0)" ::: "memory"); }
    }
    for (int i = i0; i < i0 + 8; ++i) {
        dil_write(pre, lds, tid);
        __syncthreads();
        const bool hn = i + 1 < i0 + 8;
        if (hn) dil_load<DIL>(pre, P, h, DIL_RS(i + 1), DIL_BLK(i + 1), tid);
        dil_compute<DIL>(a, qf, b, h, DIL_RS(i), DIL_BLK(i), DIL_RS(i + 1), DIL_BLK(i + 1), hn, lds, tid);
        __syncthreads();
    }
#undef DIL_RS
#undef DIL_BLK
    if (DIL != 1) {
        asm volatile("s_waitcnt vmcnt(0)" ::: "memory");
        __syncthreads();
        if (tid == 0) { __builtin_amdgcn_fence(__ATOMIC_RELEASE, "agent"); asm volatile("s_waitcnt vmcnt(0)" ::: "memory");
            __hip_atomic_store(flags + part * 64, 1u, __ATOMIC_RELAXED, __HIP_MEMORY_SCOPE_AGENT); }
    }
}

__device__ __forceinline__ void mixer_phase(const Args& a, int l, LAS unsigned char* lds, int tid, int G) {
    const float lam_init = 0.8f - 0.6f * expf(-0.3f * (float)l);
    float lam;
    { const float* lf = a.in[10] + l * 256; const int lane = tid & 63;
      const float s1 = wave_sum(lf[lane] * lf[64 + lane]), s2 = wave_sum(lf[128 + lane] * lf[192 + lane]);
      lam = expf(s1) - expf(s2) + lam_init; }
    volatile LAS int* qslot = (volatile LAS int*)(lds + MISC_OFF + 64);
    unsigned* ctr = (unsigned*)(a.ws + WS_CTL) + CW_Q + 64 * l;
    constexpr int U_KN = 16, U_SSA = U_KN + 112, U_RTA = U_SSA + 224, U_D16 = U_RTA + 128, U_D4 = U_D16 + 128, U_SSB = U_D4 + 128, U_RET = U_SSB + 256, U_DL2 = U_RET + 128;
#define Q_NEXT() do { __syncthreads(); if (tid == 0) *qslot = (int)__hip_atomic_fetch_add(ctr, 1u, __ATOMIC_RELAXED, __HIP_MEMORY_SCOPE_AGENT); __syncthreads(); u = *qslot; } while (0)
    int u; Q_NEXT();
    while (u < U_KN) { kn_unit(a, l, u >> 1, u & 1, tid); Q_NEXT(); }
    while (u < U_SSA) { const int v = u - U_KN; const int sg = v >> 4, bg = v & 15; ssd_unit_mfma<0>(a, l, bg >> 1, bg & 1, sg, lds, tid); Q_NEXT(); }
    while (u < U_RTA) { const int v = u - U_SSA; const int sg = v >> 5, bh = v & 31; ret_unit_mfma<0>(a, l, bh >> 2, bh & 3, sg, lds, tid); Q_NEXT(); }
    while (u < U_D16) { const int v = u - U_RTA; const int part = v >> 6, bh = v & 63; dil_unit_mfma<16>(a, l, bh >> 3, bh & 7, part, lds, tid); Q_NEXT(); }
    while (u < U_D4) { const int v = u - U_D16; const int part = 2 + (v >> 6), bh = v & 63; dil_unit_mfma<4>(a, l, bh >> 3, bh & 7, part, lds, tid); Q_NEXT(); }
    while (u < U_SSB) { const int v = u - U_D4; const int sg = v >> 4, bg = v & 15; ssd_unit_mfma<1>(a, l, bg >> 1, bg & 1, sg, lds, tid); Q_NEXT(); }
    while (u < U_RET) { const int v = u - U_SSB; const int sg = v >> 5, bh = v & 31; ret_unit_mfma<1>(a, l, bh >> 2, bh & 3, sg, lds, tid); Q_NEXT(); }
    while (u < U_DL2) { const int v = u - U_RET; const int part = 4 + (v >> 6), bh = v & 63; dil_unit_mfma<1>(a, l, bh >> 3, bh & 7, part, lds, tid); Q_NEXT(); }
    constexpr int NU0 = (CVT_NITEMS - CVT_I_IN) / 64, NCV = (CVT_NITEMS + 63) / 64, ND1 = 28 * 32;
    const int nf0 = (l == 0) ? NU0 : 0, nf = nf0 + ((l + 1 < DEPTH) ? NCV : 0);
    const int wv = __builtin_amdgcn_readfirstlane(tid >> 6);
#pragma nounroll
    for (int grp = 0; grp < 2; ++grp) {
        const int gb = U_DL2 + (grp == 0 ? 0 : ND1 + nf), ge = gb + (grp == 0 ? ND1 : 1024 - ND1), v0 = grp == 0 ? 0 : ND1;
        while (u < ge) { const int v = v0 + (u - gb); const int qb = 31 - (v >> 5), bh = v & 31; diff_unit_mfma(a, l, bh >> 2, bh & 3, qb, lam, lam_init, lds, tid); Q_NEXT(); }
        if (grp == 0) {
            while (u < ge + nf) { const int f = u - ge;
                if (l == 0 && f < nf0) { const int i0 = CVT_I_IN + f * 64; convert_weights(a, 0, lds, i0 + wv, i0 + 64, 8, wv, tid & 63); }
                else if (l + 1 < DEPTH) { const int i0 = (f - nf0) * 64; convert_weights(a, l + 1 < DEPTH ? l + 1 : l, lds, i0 + wv, (i0 + 64 < CVT_NITEMS ? i0 + 64 : CVT_NITEMS), 8, wv, tid & 63); }
                Q_NEXT(); } }
    }
#undef Q_NEXT
}

__global__ void __launch_bounds__(NWAVES * 64, 2) hybrid_fwd(Args args) {
    extern __shared__ __attribute__((aligned(16))) unsigned char lds_raw[];
    LAS unsigned char* lds = (LAS unsigned char*)lds_raw;
    volatile LAS unsigned* MISC = (volatile LAS unsigned*)(lds + MISC_OFF);
    const int tid = threadIdx.x, lane = tid & 63, wave = __builtin_amdgcn_readfirstlane(tid >> 6);
    const int G = gridDim.x;
    const int vcu = (G % 8 == 0) ? ((int)blockIdx.x % 8) * (G / 8) + (int)blockIdx.x / 8 : (int)blockIdx.x;
    const int gw = vcu * NWAVES + wave, NGW = G * NWAVES;
    unsigned char* ws = args.ws;
    gu32* ctl = (gu32*)(ws + WS_CTL);
    for (int u = tid; u < (LDS_BYTES - LDSCTL_OFF) / 4; u += NWAVES * 64) ((LAS unsigned*)(lds + LDSCTL_OFF))[u] = 0u;
    __syncthreads();
    XcdBarrier bar; bar.bar = (unsigned*)(ctl + CW_BAR); bar.x = 0; bar.st = nullptr;
    if (MK_N_LAUNCHES == 1) bar = xcd_barrier_post((unsigned*)(ctl + CW_BAR), MISC + 8);
#define GRID_BAR() do { if (MK_N_LAUNCHES == 1) xcd_barrier(bar); } while (0)
    const int lo = args.ph_lo, hi = args.ph_hi;
#define IN(k) (lo <= (k) && (k) < hi)
#define BOTH(k) (IN(k) && IN((k) + 1))
    bf16* H = (bf16*)(ws + WS_XB); float* RINV = (float*)(ws + WS_RINV); bf16* MIXB = (bf16*)(ws + WS_MIX); bf16* PROJ = (bf16*)(ws + WS_PROJ);
    bf16* Y1 = PROJ; bf16* HID = PROJ; bf16* Y2 = MIXB;

    if (IN(0)) {
        convert_weights(args, 0, lds, gw, CVT_I_IN, NGW, wave, lane);
        thin_rows<0>(args.in[0], H, RINV, nullptr, nullptr, nullptr, gw, NGW, lane, args.in[2] + 3072, args.in[1], (float*)(ws + WS_DT), lds);
        if (BOTH(0)) GRID_BAR();
    }
#define LAYER_BODY(l) do { \
        const int pb = 1 + 7 * (l); \
        if (IN(pb)) { \
            pg8::Gemm g{H, (const bf16*)(ws + WS_W0 + (size_t)((l) & 1) * WBUF + WO_IN), M, LDP, DM}; pg8::StaticOrder S; S.init(M, LDP, G, (int)blockIdx.x); \
            pg8::EpiProj E{PROJ, LDP, (bf16*)(ws + WS_DQKV)}; \
            pg8::gemm_phase<pg8::EpiProj, pg8::StaticOrder, true, true>(lds + RING_OFF, g, S, E); \
            if (BOTH(pb)) GRID_BAR(); \
        } \
        if (IN(pb + 1)) { \
            mixer_phase(args, l, lds, tid, G); \
            if (BOTH(pb + 1)) GRID_BAR(); \
        } \
        if (IN(pb + 2)) { \
            pg8::Gemm g{MIXB, (const bf16*)(ws + WS_W0 + (size_t)((l) & 1) * WBUF + WO_OUT), M, DM, DM}; pg8::StaticOrder S; S.init(M, DM, G, (int)blockIdx.x); \
            pg8::EpiBf16 E{Y1, DM}; \
            pg8::gemm_phase<pg8::EpiBf16, pg8::StaticOrder, true, true>(lds + RING_OFF, g, S, E); \
            if (BOTH(pb + 2)) GRID_BAR(); \
        } \
        if (IN(pb + 3)) { \
            thin_rows<1>(nullptr, H, RINV, Y1, args.in[13] + l * DM, nullptr, gw, NGW, lane); \
            if (BOTH(pb + 3)) GRID_BAR(); \
        } \
        if (IN(pb + 4)) { \
            pg8::Gemm g{H, (const bf16*)(ws + WS_W0 + (size_t)((l) & 1) * WBUF + WO_GU), M, 2 * FFN, DM}; pg8::StaticOrder S; S.init(M, 2 * FFN, G, (int)blockIdx.x); \
            pg8::EpiSwiGLU E{HID, FFN}; \
            pg8::gemm_phase<pg8::EpiSwiGLU, pg8::StaticOrder, true, true>(lds + RING_OFF, g, S, E); \
            if (BOTH(pb + 4)) GRID_BAR(); \
        } \
        if (IN(pb + 5)) { \
            pg8::Gemm g{HID, (const bf16*)(ws + WS_W0 + (size_t)((l) & 1) * WBUF + WO_D), M, DM, FFN}; pg8::StaticOrder S; S.init(M, DM, G, (int)blockIdx.x); \
            pg8::EpiBf16 E{Y2, DM}; \
            pg8::gemm_phase<pg8::EpiBf16, pg8::StaticOrder, true, true>(lds + RING_OFF, g, S, E); \
            if (BOTH(pb + 5)) GRID_BAR(); \
        } \
        if (IN(pb + 6)) { \
            if ((l) + 1 < DEPTH) thin_rows<1>(nullptr, H, RINV, Y2, args.in[18] + l * DM, nullptr, gw, NGW, lane, args.in[2] + (size_t)((l) + 1 < DEPTH ? (l) + 1 : 0) * DM * IN_COLS + 3072, args.in[1] + ((l) + 1 < DEPTH ? (l) + 1 : 0) * DM, (float*)(ws + WS_DT), lds); \
            else thin_rows<2>(nullptr, H, RINV, Y2, args.in[18] + l * DM, args.out, gw, NGW, lane); \
            if (BOTH(pb + 6)) GRID_BAR(); \
        } \
    } while (0)
    LAYER_BODY(0); LAYER_BODY(1); LAYER_BODY(2); LAYER_BODY(3);
#undef LAYER_BODY
#undef IN
#undef BOTH
#undef GRID_BAR
}

extern "C" void kernel_launch(void* const* d_in, const int* in_sizes, int n_in, void* d_out, int out_size, void* d_ws, size_t ws_size, hipStream_t stream) {
    static int grid = 0;
    if (grid == 0) {
        if (n_in != 19 || in_sizes[0] != M * DM || out_size != M * DM || ws_size < WS_END) { fprintf(stderr, "kernel_launch: unexpected shapes (n_in %d, in0 %d, out %d, ws %zu); nothing launched\n", n_in, n_in > 0 ? in_sizes[0] : -1, out_size, ws_size); grid = -1; return; }
        int dev = 0, cus = 0, per_cu = 0;
        if (hipGetDevice(&dev) != hipSuccess || hipDeviceGetAttribute(&cus, hipDeviceAttributeMultiprocessorCount, dev) != hipSuccess) { grid = -1; return; }
        if (hipFuncSetAttribute((const void*)hybrid_fwd, hipFuncAttributeMaxDynamicSharedMemorySize, LDS_BYTES) != hipSuccess) { fprintf(stderr, "kernel_launch: hipFuncSetAttribute failed\n"); grid = -1; return; }
        if (hipOccupancyMaxActiveBlocksPerMultiprocessor(&per_cu, (const void*)hybrid_fwd, NWAVES * 64, LDS_BYTES) != hipSuccess || per_cu < 1)
            fprintf(stderr, "kernel_launch: note: occupancy query reports %d workgroups per CU\n", per_cu);
        (void)hipGetLastError();
        grid = cus;
    }
    if (grid < 0) return;
    if (hipMemsetAsync((char*)d_ws + WS_CTL, 0, CTL_ZERO_BYTES, stream) != hipSuccess) return;
    Args a{};
    for (int i = 0; i < 19; ++i) a.in[i] = (const float*)d_in[i];
    a.out = (float*)d_out; a.ws = (unsigned char*)d_ws; a.pad = 0;
    if (MK_N_LAUNCHES == 1) {
        a.ph_lo = 0; a.ph_hi = N_PHASES; a.li = 0;
        hipLaunchKernelGGL(hybrid_fwd, dim3(grid), dim3(NWAVES * 64), LDS_BYTES, stream, a);
    } else {
        for (int li = 0; li < N_PHASES; ++li) { a.ph_lo = li; a.ph_hi = li + 1; a.li = li;
            hipLaunchKernelGGL(hybrid_fwd, dim3(grid), dim3(NWAVES * 64), LDS_BYTES, stream, a); }
    }
}
```

```cpp
#include <hip/hip_runtime.h>
#include <cstdio>
#include <cstdint>

#ifndef MK_N_LAUNCHES
#define MK_N_LAUNCHES 1
#endif

namespace pg8 {
#define PG8_LAS __attribute__((address_space(3)))
typedef unsigned short bf16_t;
typedef short bf16x8 __attribute__((ext_vector_type(8)));
typedef float f32x4 __attribute__((ext_vector_type(4)));
typedef unsigned u32x4 __attribute__((ext_vector_type(4)));
constexpr int BM = 256, BK = 64, HALF = 128, HTB = HALF * BK * 2, STAGE_BYTES = 8 * HTB, NXCD = 8, WGM = 8;

__host__ __device__ __forceinline__ int lds_byte(int r, int c) { const int st = (r >> 4) * 2 + (c >> 5), rr = r & 15, cc = c & 31, ob = rr * 64 + cc * 2; return st * 1024 + (ob ^ (((ob >> 9) & 1) << 5)); }
__host__ __device__ __forceinline__ void stage_rc(int b, int& R, int& C) { const int st = b / 1024, sb = b % 1024, swz = sb ^ (((sb >> 9) & 1) << 5); R = (st >> 1) * 16 + swz / 64; C = (st & 1) * 32 + (swz % 64) / 2; }
__host__ __device__ __forceinline__ int perm32(int rho) { const int n = rho >> 4, i = rho & 15; return 8 * (i >> 2) + 4 * n + (i & 3); }

struct Unit { int pm, pn; };
struct Gemm { const bf16_t* A; const bf16_t* Bt; int M, N, K; };

struct StaticOrder {
    int nM, nN, nwg, G, c;
    __host__ __device__ void init(int M, int N, int G_, int c_) { nM = M / BM; nN = N / BM; nwg = nM * nN; G = G_; c = c_; }
    __host__ __device__ bool next(int i, Unit& u) const {
        const long L = (long)i * G + c; if (L >= nwg) return false;
        int wgid = (int)L; { const int q = nwg / NXCD, r = nwg % NXCD, xcd = wgid % NXCD, off = wgid / NXCD; wgid = (xcd < r ? xcd * (q + 1) : r * (q + 1) + (xcd - r) * q) + off; }
        const int nig = WGM * nN, gid = wgid / nig, fm = gid * WGM, gsz = (nM - fm) < WGM ? (nM - fm) : WGM;
        u.pm = fm + ((wgid % nig) % gsz); u.pn = (wgid % nig) / gsz; return true;
    }
    __device__ __forceinline__ void a_ready(const Unit&) const {}
    __device__ __forceinline__ void done(const Unit&) const {}
};

__device__ __forceinline__ unsigned cvt_pk_bf16(float lo, float hi) { unsigned r; asm volatile("v_cvt_pk_bf16_f32 %0, %1, %2" : "=v"(r) : "v"(lo), "v"(hi)); return r; }

struct EpiBf16 {
    static constexpr bool PERM = true, AFTER_DRAIN = false;
    bf16_t* O; int ldc;
    __device__ __forceinline__ void operator()(const f32x4 (&acc)[2][2][4][2], const Unit& u, int wr, int wc, int fr, int fq) const {
        const int row0 = u.pm * BM + wr * 64 + fr; const int col0 = u.pn * BM + wc * 32 + 8 * fq;
#pragma unroll
        for (int ai = 0; ai < 2; ++ai)
#pragma unroll
            for (int m = 0; m < 4; ++m) { bf16_t* rowp = O + (size_t)(row0 + ai * HALF + m * 16) * ldc + col0;
#pragma unroll
                for (int bj = 0; bj < 2; ++bj) { const f32x4 v0 = acc[ai][bj][m][0], v1 = acc[ai][bj][m][1];
                    u32x4 w; w.x = cvt_pk_bf16(v0[0], v0[1]); w.y = cvt_pk_bf16(v0[2], v0[3]); w.z = cvt_pk_bf16(v1[0], v1[1]); w.w = cvt_pk_bf16(v1[2], v1[3]);
                    *(u32x4*)(rowp + bj * HALF) = w; } }
    }
};
struct EpiProj {
    static constexpr bool PERM = true, AFTER_DRAIN = false;
    bf16_t* O; int ldc; bf16_t* C;
    __device__ __forceinline__ void operator()(const f32x4 (&acc)[2][2][4][2], const Unit& u, int wr, int wc, int fr, int fq) const {
        if (u.pn < 18) { EpiBf16 e{O, ldc}; e(acc, u, wr, wc, fr, fq); return; }
        const int sel = (u.pn - 18) >> 1, hb = ((u.pn - 18) & 1) * 4;
        const int row0 = u.pm * BM + wr * 64 + fr; const int c0 = wc * 32 + 8 * fq;
#pragma unroll
        for (int ai = 0; ai < 2; ++ai)
#pragma unroll
            for (int m = 0; m < 4; ++m) { const int row = row0 + ai * HALF + m * 16; const int b = row >> 12, t = row & 4095;
#pragma unroll
                for (int bj = 0; bj < 2; ++bj) { const int c = c0 + bj * HALF; const int h = hb + (c >> 6), d = c & 63;
                    bf16_t* dst = C + ((size_t)(((b * 8 + h) * 16 + (t & 15)) * 256 + (t >> 4))) * 192 + sel * 64 + d;
                    const f32x4 v0 = acc[ai][bj][m][0], v1 = acc[ai][bj][m][1];
                    u32x4 w; w.x = cvt_pk_bf16(v0[0], v0[1]); w.y = cvt_pk_bf16(v0[2], v0[3]); w.z = cvt_pk_bf16(v1[0], v1[1]); w.w = cvt_pk_bf16(v1[2], v1[3]);
                    *(u32x4*)dst = w; } }
    }
};
__device__ __forceinline__ float silu_mul(float g, float u) { return g * u * __builtin_amdgcn_rcpf(1.0f + __builtin_amdgcn_exp2f(-g)); }
struct EpiSwiGLU {
    static constexpr bool PERM = true, AFTER_DRAIN = false;
    bf16_t* O; int ldc;
    __device__ __forceinline__ void operator()(const f32x4 (&acc)[2][2][4][2], const Unit& u, int wr, int wc, int fr, int fq) const {
        const int row0 = u.pm * BM + wr * 64 + fr; const int col0 = u.pn * HALF + wc * 32 + 8 * fq;
#pragma unroll
        for (int ai = 0; ai < 2; ++ai)
#pragma unroll
            for (int m = 0; m < 4; ++m) { bf16_t* rowp = O + (size_t)(row0 + ai * HALF + m * 16) * ldc + col0;
                const f32x4 g0 = acc[ai][0][m][0], g1 = acc[ai][0][m][1], u0 = acc[ai][1][m][0], u1 = acc[ai][1][m][1];
                u32x4 w; w.x = cvt_pk_bf16(silu_mul(g0[0], u0[0]), silu_mul(g0[1], u0[1])); w.y = cvt_pk_bf16(silu_mul(g0[2], u0[2]), silu_mul(g0[3], u0[3]));
                w.z = cvt_pk_bf16(silu_mul(g1[0], u1[0]), silu_mul(g1[1], u1[1])); w.w = cvt_pk_bf16(silu_mul(g1[2], u1[2]), silu_mul(g1[3], u1[3]));
                *(u32x4*)rowp = w; }
    }
};

template <class Epi, class Sched, bool ALIGN_EPI = false, bool SP2 = false>
__device__ __forceinline__ void gemm_phase(PG8_LAS unsigned char* lds, const Gemm g, const Sched& S, const Epi& E) {
    int tid = threadIdx.x; asm volatile("" : "+v"(tid));
    const int wid = __builtin_amdgcn_readfirstlane(tid >> 6), lane = tid & 63, wr = wid >> 2, wc = wid & 3, fr = lane & 15, fq = lane >> 4;
    const int K = g.K, nt = K / BK;
    unsigned voffA[2], voffB[2];
#pragma unroll
    for (int i = 0; i < 2; ++i) { int R, C; stage_rc(tid * 16 + i * 8192, R, C); const int Rb = Epi::PERM ? ((R & ~31) + perm32(R & 31)) : R;
        voffA[i] = (unsigned)(R * K + C) * 2u; voffB[i] = (unsigned)(Rb * K + C) * 2u; }
    const size_t kstep = (size_t)(BK * 2);
    const size_t hstep = (size_t)HALF * K * 2;
    const size_t tstep = 2 * hstep;
    const unsigned ldsw = (unsigned)wid * 1024u;
    const int aoff = lds_byte(wr * 64 + fr, fq * 8), boff = lds_byte(wc * 32 + fr, fq * 8);
#define PG8_SA(b, h) (((b) * 2 + (h)) * HTB)
#define PG8_SB(b, h) ((4 + (b) * 2 + (h)) * HTB)
#define PG8_STAGE(bufoff, gbase, voff) do { _Pragma("unroll") for (int _i = 0; _i < 2; ++_i) \
        __builtin_amdgcn_global_load_lds((const unsigned*)((const char*)(gbase) + (voff)[_i]), (PG8_LAS unsigned*)(lds + (bufoff) + ldsw + _i * 8192), 16, 0, 0); } while (0)
#define PG8_LDA(dst, b, h) do { _Pragma("unroll") for (int m = 0; m < 4; ++m) _Pragma("unroll") for (int k = 0; k < 2; ++k) dst[m][k] = *(const PG8_LAS bf16x8*)(lds + PG8_SA(b, h) + aoff + m * 2048 + k * 1024); } while (0)
#define PG8_LDB(dst, b, h) do { _Pragma("unroll") for (int n = 0; n < 2; ++n) _Pragma("unroll") for (int k = 0; k < 2; ++k) dst[n][k] = *(const PG8_LAS bf16x8*)(lds + PG8_SB(b, h) + boff + n * 2048 + k * 1024); } while (0)
#define PG8_MMA(ai, bj, At, Bt) do { __builtin_amdgcn_s_setprio(1); _Pragma("unroll") for (int m = 0; m < 4; ++m) _Pragma("unroll") for (int n = 0; n < 2; ++n) _Pragma("unroll") for (int k = 0; k < 2; ++k) \
        acc[ai][bj][m][n] = __builtin_amdgcn_mfma_f32_16x16x32_bf16(Bt[n][k], At[m][k], acc[ai][bj][m][n], 0, 0, 0); __builtin_amdgcn_s_setprio(0); } while (0)
#define PG8_WAIT_V(n) asm volatile("s_waitcnt vmcnt(" #n ")" ::: "memory")
#define PG8_WAIT_L(n) asm volatile("s_waitcnt lgkmcnt(" #n ")" ::: "memory")
#define PG8_BAR __builtin_amdgcn_s_barrier()
#define PG8_SCHED __builtin_amdgcn_sched_barrier(0)
    Unit cur, nxt; int ui = 0;
    if (!S.next(0, cur)) return;
    f32x4 acc[2][2][4][2];
#pragma unroll
    for (int a = 0; a < 2; ++a)
#pragma unroll
        for (int b = 0; b < 2; ++b)
#pragma unroll
            for (int m = 0; m < 4; ++m)
#pragma unroll
                for (int n = 0; n < 2; ++n) acc[a][b][m][n] = (f32x4){0.f, 0.f, 0.f, 0.f};
    bf16x8 At[4][2], B0[2][2], B1[2][2];
    const char* cA = (const char*)g.A + (size_t)cur.pm * tstep; const char* cB = (const char*)g.Bt + (size_t)cur.pn * tstep;
    S.a_ready(cur);
    if constexpr (SP2) {
        PG8_STAGE(PG8_SB(0, 0), cB, voffB); PG8_STAGE(PG8_SB(0, 1), cB + hstep, voffB); PG8_STAGE(PG8_SA(0, 0), cA, voffA); PG8_STAGE(PG8_SA(0, 1), cA + hstep, voffA);
        if (wr == 1) PG8_BAR;
        PG8_WAIT_V(2); PG8_BAR;
        PG8_STAGE(PG8_SB(1, 0), cB + kstep, voffB); PG8_STAGE(PG8_SA(1, 0), cA + kstep, voffA); PG8_STAGE(PG8_SB(1, 1), cB + hstep + kstep, voffB);
        PG8_WAIT_V(6); PG8_BAR;
    } else {
        PG8_STAGE(PG8_SB(0, 0), cB, voffB); PG8_STAGE(PG8_SA(0, 0), cA, voffA); PG8_STAGE(PG8_SB(0, 1), cB + hstep, voffB); PG8_STAGE(PG8_SA(0, 1), cA + hstep, voffA);
        if (wr == 1) PG8_BAR;
        PG8_WAIT_V(4); PG8_BAR;
        PG8_STAGE(PG8_SB(1, 0), cB + kstep, voffB); PG8_STAGE(PG8_SA(1, 0), cA + kstep, voffA); PG8_STAGE(PG8_SB(1, 1), cB + hstep + kstep, voffB);
        PG8_WAIT_V(6); PG8_BAR;
    }
    for (;;) {
        const bool has_next = S.next(ui + 1, nxt);
        const char* nA = has_next ? (const char*)g.A + (size_t)nxt.pm * tstep : cA; const char* nB = has_next ? (const char*)g.Bt + (size_t)nxt.pn * tstep : cB;
        for (int t = 0; t < nt; t += 2) {
            const bool last = (t == nt - 2);
            const char* a1 = cA + (size_t)(t + 1) * kstep;
            const char* a2 = last ? nA : cA + (size_t)(t + 2) * kstep; const char* b2 = last ? nB : cB + (size_t)(t + 2) * kstep;
            const char* a3 = a2 + kstep; const char* b3 = b2 + kstep;
            if (last && has_next) S.a_ready(nxt);
            if constexpr (SP2) {
            PG8_LDB(B0, 0, 0); PG8_LDB(B1, 0, 1); PG8_SCHED; PG8_LDA(At, 0, 0); PG8_STAGE(PG8_SA(1, 1), a1 + hstep, voffA);
            PG8_WAIT_V(8); PG8_WAIT_L(0); PG8_BAR; PG8_MMA(0, 0, At, B0); PG8_MMA(0, 1, At, B1); PG8_BAR; PG8_SCHED;
            PG8_LDA(At, 0, 1); PG8_STAGE(PG8_SB(0, 0), b2, voffB); PG8_STAGE(PG8_SB(0, 1), b2 + hstep, voffB); PG8_STAGE(PG8_SA(0, 0), a2, voffA);
            PG8_WAIT_V(8); PG8_WAIT_L(0); PG8_BAR; PG8_MMA(1, 0, At, B0); PG8_MMA(1, 1, At, B1); PG8_BAR; PG8_SCHED;
            PG8_LDB(B0, 1, 0); PG8_LDB(B1, 1, 1); PG8_SCHED; PG8_LDA(At, 1, 0); PG8_STAGE(PG8_SA(0, 1), a2 + hstep, voffA);
            PG8_WAIT_V(8); PG8_WAIT_L(0); PG8_BAR; PG8_MMA(0, 0, At, B0); PG8_MMA(0, 1, At, B1); PG8_BAR; PG8_SCHED;
            PG8_LDA(At, 1, 1); PG8_STAGE(PG8_SB(1, 0), b3, voffB); PG8_STAGE(PG8_SB(1, 1), b3 + hstep, voffB); PG8_STAGE(PG8_SA(1, 0), a3, voffA);
            PG8_WAIT_V(8); PG8_WAIT_L(0); PG8_BAR; PG8_MMA(1, 0, At, B0); PG8_MMA(1, 1, At, B1); PG8_BAR; PG8_SCHED;
            } else {
            PG8_LDB(B0, 0, 0); PG8_SCHED; PG8_LDA(At, 0, 0); PG8_STAGE(PG8_SA(1, 1), a1 + hstep, voffA);
            PG8_WAIT_L(8); PG8_BAR; PG8_WAIT_L(0); PG8_MMA(0, 0, At, B0); PG8_BAR; PG8_SCHED;
            PG8_LDB(B1, 0, 1); PG8_STAGE(PG8_SB(0, 0), b2, voffB);
            PG8_BAR; PG8_WAIT_L(0); PG8_MMA(0, 1, At, B1); PG8_BAR;
            PG8_LDA(At, 0, 1); PG8_STAGE(PG8_SA(0, 0), a2, voffA);
            PG8_BAR; PG8_WAIT_L(0); PG8_MMA(1, 0, At, B0); PG8_BAR; PG8_SCHED;
            PG8_STAGE(PG8_SB(0, 1), b2 + hstep, voffB);
            PG8_WAIT_V(6); PG8_BAR; PG8_MMA(1, 1, At, B1); PG8_BAR;
            PG8_LDB(B0, 1, 0); PG8_SCHED; PG8_LDA(At, 1, 0); PG8_STAGE(PG8_SA(0, 1), a2 + hstep, voffA);
            PG8_WAIT_L(8); PG8_BAR; PG8_WAIT_L(0); PG8_MMA(0, 0, At, B0); PG8_BAR; PG8_SCHED;
            PG8_LDB(B1, 1, 1); PG8_STAGE(PG8_SB(1, 0), b3, voffB);
            PG8_BAR; PG8_WAIT_L(0); PG8_MMA(0, 1, At, B1); PG8_BAR;
            PG8_LDA(At, 1, 1); PG8_STAGE(PG8_SA(1, 0), a3, voffA);
            PG8_BAR; PG8_WAIT_L(0); PG8_MMA(1, 0, At, B0); PG8_BAR; PG8_SCHED;
            PG8_STAGE(PG8_SB(1, 1), b3 + hstep, voffB);
            PG8_WAIT_V(6); PG8_BAR; PG8_MMA(1, 1, At, B1); PG8_BAR;
            }
        }
        if constexpr (ALIGN_EPI) { if (wr == 0) PG8_BAR; }
        if constexpr (!Epi::AFTER_DRAIN) { E(acc, cur, wr, wc, fr, fq); S.done(cur); }
        if (!has_next) break;
#pragma unroll
        for (int a = 0; a < 2; ++a)
#pragma unroll
            for (int b = 0; b < 2; ++b)
#pragma unroll
                for (int m = 0; m < 4; ++m)
#pragma unroll
                    for (int n = 0; n < 2; ++n) acc[a][b][m][n] = (f32x4){0.f, 0.f, 0.f, 0.f};
        cur = nxt; cA = nA; cB = nB; ++ui;
        if constexpr (ALIGN_EPI) { if (wr == 1) PG8_BAR; }
    }
    PG8_WAIT_V(0);
    if constexpr (!ALIGN_EPI) { if (wr == 0) PG8_BAR; }
    PG8_BAR;
#undef PG8_SA
#undef PG8_SB
#undef PG8_STAGE
#undef PG8_LDA
#undef PG8_LDB
#undef PG8_MMA
#undef PG8_WAIT_V
#undef PG8_WAIT_L
#undef PG8_BAR
#undef PG8_SCHED
}
}

constexpr int NWAVES = 8;
constexpr int BATCH = 8, SEQ = 4096, DM = 2048, DEPTH = 4;
constexpr int M = BATCH * SEQ;
constexpr int IN_COLS = 6152, LDP = 6144;
constexpr int FFN = 5632;
constexpr float NORM_EPS = 1e-6f;
constexpr int C_RQ = 0, C_RK = 256, C_RV = 512, C_RG = 1024, C_SZ = 1536, C_SXBC = 2048, C_DQ = 3072, C_DK = 3584, C_DV = 4096, C_LQ = 4608, C_LK = 5120, C_LV = 5632, C_DT = 6144;
constexpr int N_PHASES = 1 + 7 * DEPTH;

constexpr size_t MiB = 1u << 20;
constexpr size_t WS_CTL = 0, CTL_ZERO_BYTES = 1 * MiB;
constexpr size_t WS_W0 = 2 * MiB, WBUF = 99 * MiB, WO_IN = 0, WO_OUT = 25 * MiB, WO_GU = 33 * MiB, WO_D = 77 * MiB;
constexpr size_t WS_MIX = 200 * MiB, WS_PROJ = 328 * MiB, WS_XB = 728 * MiB, WS_DT = 856 * MiB, WS_RINV = 857 * MiB, WS_DQKV = 858 * MiB, WS_END = 954 * MiB;
constexpr size_t OS_DILO = 0, OS_DILL = 64 * MiB, OS_SSDS = 66 * MiB, OS_SSDL = 82 * MiB, OS_RETS = 83 * MiB;
constexpr int CW_BAR = 4096, CW_Q = 16384, CW_FLAG = 32768, CW_FLAG2 = 65536, CW_FLAG3 = 131072, CW_KNF = 196608, CW_KN = 204800;

constexpr int RING_OFF = 0, RING_BYTES = 131072;
constexpr int LDSCTL_OFF = RING_BYTES, MISC_OFF = LDSCTL_OFF + 320;
constexpr int LDS_BYTES = 147456;

#define GAS __attribute__((address_space(1)))
#define LAS __attribute__((address_space(3)))
typedef unsigned short bf16;
typedef unsigned v4u __attribute__((ext_vector_type(4)));
typedef unsigned v2u __attribute__((ext_vector_type(2)));
typedef float f32x4 __attribute__((ext_vector_type(4)));
typedef GAS unsigned gu32;
#define RLX_AGENT __ATOMIC_RELAXED, __HIP_MEMORY_SCOPE_AGENT
#define LDS_WAIT() asm volatile("s_waitcnt lgkmcnt(0)" ::: "memory")
#define VM_WAIT() asm volatile("s_waitcnt vmcnt(0)" ::: "memory")
__device__ __forceinline__ unsigned f2bf(float f) { unsigned u = __builtin_bit_cast(unsigned, f); return (u + 0x7fffu + ((u >> 16) & 1u)) >> 16; }
__device__ __forceinline__ unsigned pk2(float lo, float hi) { return f2bf(lo) | (f2bf(hi) << 16); }
__device__ __forceinline__ float bflo(unsigned w) { return __uint_as_float(w << 16); }
__device__ __forceinline__ float bfhi(unsigned w) { return __uint_as_float(w & 0xffff0000u); }
__device__ __forceinline__ float ldbf(const bf16* p) { return __uint_as_float(((unsigned)*p) << 16); }
__device__ __forceinline__ float silu_f(float x) { return x / (1.f + __expf(-x)); }

#define XB_TMO      128
#define XB_XCNT(j)  (256  + 64 * (j))
#define XB_XSUB(j)  (1280 + 64 * (j))
#define XB_XGEN(j)  (2304 + 64 * (j))
#define XB_TOP      3328
#define XB_TOPGEN   3392
#define XCD_BAR_WORDS 3456
#define XB_SPIN_CAP (1u << 18)
__device__ __forceinline__ unsigned xb_ld(unsigned* p)              { return __hip_atomic_load(p, __ATOMIC_RELAXED, __HIP_MEMORY_SCOPE_AGENT); }
__device__ __forceinline__ unsigned xb_add(unsigned* p, unsigned v) { return __hip_atomic_fetch_add(p, v, __ATOMIC_RELAXED, __HIP_MEMORY_SCOPE_AGENT); }
__device__ __forceinline__ unsigned xb_xcc_id() { return (unsigned)__builtin_amdgcn_s_getreg((3 << 11) | 20) & 0xFu; }
#define XB_SPIN(cond, bar) do { unsigned _sp = 0; while (cond) { __builtin_amdgcn_s_sleep(1); \
    if ((++_sp & 255u) == 0u) { if (xb_ld(&(bar)[XB_TMO])) break; if (_sp > XB_SPIN_CAP) { atomicAdd(&(bar)[XB_TMO], 1u); break; } } } } while (0)
struct XcdBarrier { unsigned* bar; unsigned x; volatile LAS unsigned* st; };
__device__ __forceinline__ XcdBarrier xcd_barrier_post(unsigned* bar, volatile LAS unsigned* st) {
    XcdBarrier b; b.bar = bar; b.x = xb_xcc_id(); b.st = st;
    if (threadIdx.x == 0) (void)xb_add(&bar[XB_XCNT(b.x)], 1u);
    return b;
}
__device__ __forceinline__ void xcd_barrier_complete(unsigned* bar, unsigned x, unsigned& nloc, unsigned& nx) {
    const unsigned G = gridDim.x * gridDim.y * gridDim.z;
    unsigned sum, cnt, mine, sp = 0u;
    for (;;) {
        sum = 0u; cnt = 0u; mine = 0u;
#pragma unroll
        for (unsigned j = 0; j < 16; ++j) { const unsigned c = xb_ld(&bar[XB_XCNT(j)]); sum += c; cnt += (c > 0u) ? 1u : 0u; mine = (j == x) ? c : mine; }
        if (sum == G) break;
        __builtin_amdgcn_s_sleep(1);
        if ((++sp & 255u) == 0u) { if (xb_ld(&bar[XB_TMO])) break; if (sp > XB_SPIN_CAP) { atomicAdd(&bar[XB_TMO], 1u); break; } }
    }
    nloc = mine > 0u ? mine : 1u; nx = cnt > 0u ? cnt : 1u;
}
__device__ __forceinline__ void xcd_barrier(const XcdBarrier& b) {
    asm volatile("s_waitcnt vmcnt(0)" ::: "memory");
    __syncthreads();
    if (threadIdx.x == 0) {
        unsigned* bar = b.bar;
        __builtin_amdgcn_s_waitcnt(0);
        unsigned nloc = b.st[0], nx = b.st[1];
        if (nloc == 0u) { xcd_barrier_complete(bar, b.x, nloc, nx); b.st[0] = nloc; b.st[1] = nx; }
        const unsigned old = xb_add(&bar[XB_XSUB(b.x)], 1u);
        const unsigned gen = old / nloc;
        if (old + 1u == (gen + 1u) * nloc) {
            __builtin_amdgcn_fence(__ATOMIC_RELEASE, "agent");
            asm volatile("s_waitcnt vmcnt(0)" ::: "memory");
            const unsigned og = xb_add(&bar[XB_TOP], 1u);
            const unsigned tg = og / nx;
            if (og + 1u == (tg + 1u) * nx) xb_add(&bar[XB_TOPGEN], 1u);
            else XB_SPIN(xb_ld(&bar[XB_TOPGEN]) == tg, bar);
            __builtin_amdgcn_fence(__ATOMIC_ACQUIRE, "agent");
            xb_add(&bar[XB_XGEN(b.x)], 1u);
            asm volatile("s_waitcnt vmcnt(0)" ::: "memory");
        } else {
            XB_SPIN(xb_ld(&bar[XB_XGEN(b.x)]) == gen, bar);
            __builtin_amdgcn_fence(__ATOMIC_ACQUIRE, "agent");
            asm volatile("s_waitcnt vmcnt(0)" ::: "memory");
        }
    }
    __syncthreads();
}

struct Args { const float* in[19]; float* out; unsigned char* ws; int ph_lo, ph_hi, li, pad; };

__device__ __forceinline__ float wave_sum(float v) {
#pragma unroll
    for (int o = 1; o < 64; o <<= 1) v += __shfl_xor(v, o);
    return v;
}


template <int CTRL> __device__ __forceinline__ float dppf(float v) { return __builtin_bit_cast(float, __builtin_amdgcn_update_dpp(0, __builtin_bit_cast(int, v), CTRL, 0xf, 0xf, true)); }
#define DPP_X1(v) dppf<0xB1>(v)
#define DPP_X2(v) dppf<0x4E>(v)
#define DPP_HM(v) dppf<0x141>(v)
#define DPP_RM(v) dppf<0x140>(v)
#define SWZ_XORF(v, k) __builtin_bit_cast(float, __builtin_amdgcn_ds_swizzle(__builtin_bit_cast(int, (float)(v)), ((k) << 10) | 0x1f))
__device__ __forceinline__ float swap32_sum(float v) { auto rr = __builtin_amdgcn_permlane32_swap(__builtin_bit_cast(unsigned, v), __builtin_bit_cast(unsigned, v), false, false); const unsigned r0 = rr[0], r1 = rr[1]; return __builtin_bit_cast(float, r0) + __builtin_bit_cast(float, r1); }

typedef float f32x2_t __attribute__((ext_vector_type(2)));
typedef __bf16 bf16x2_t __attribute__((ext_vector_type(2)));
__device__ __forceinline__ unsigned cvtpk(float lo, float hi) { f32x2_t v = {lo, hi}; bf16x2_t b = __builtin_convertvector(v, bf16x2_t); return __builtin_bit_cast(unsigned, b); }
__device__ __forceinline__ unsigned cvtpk1(float v) { return cvtpk(v, v) & 0xffffu; }
__device__ __forceinline__ float wave_sum_fast(float d) { d += DPP_X1(d); d += DPP_X2(d); d += DPP_HM(d); d += DPP_RM(d); d += SWZ_XORF(d, 16); return swap32_sum(d); }

struct CvtItem { const float* src; bf16* dst; const float* gain; int ldw, K; float sc; };
constexpr int CVT_I_IN = 192 * 32, CVT_I_OUT = 64 * 32, CVT_I_G = 176 * 32, CVT_I_D = 64 * 88, CVT_NITEMS = CVT_I_IN + CVT_I_OUT + 2 * CVT_I_G + CVT_I_D;
__device__ __forceinline__ CvtItem cvt_decode(const Args& a, int l, int it) {
    const float* Win = a.in[2] + (size_t)l * DM * IN_COLS; const float* Wout = a.in[12] + (size_t)l * DM * DM;
    const float* Wg = a.in[15] + (size_t)l * DM * FFN; const float* Wu = a.in[16] + (size_t)l * DM * FFN; const float* Wd = a.in[17] + (size_t)l * FFN * DM;
    unsigned char* wb = a.ws + WS_W0 + (size_t)(l & 1) * WBUF;
    bf16* WinT = (bf16*)(wb + WO_IN); bf16* WoutT = (bf16*)(wb + WO_OUT); bf16* WguT = (bf16*)(wb + WO_GU); bf16* WdT = (bf16*)(wb + WO_D);
    const float* gmix = a.in[1] + l * DM; const float* gffn = a.in[14] + l * DM;
    CvtItem c; c.sc = 1.f; int r = it;
    if (r < CVT_I_IN) { const int kb = r / 192, nb = r % 192; const int sc = nb < 96 ? 32 * nb : 3080 + 32 * (nb - 96);
        c.src = Win + (size_t)(64 * kb) * IN_COLS + sc; c.ldw = IN_COLS; c.dst = WinT + (size_t)(32 * nb) * DM + 64 * kb; c.K = DM; c.gain = gmix + 64 * kb; return c; } r -= CVT_I_IN;
    if (r < CVT_I_OUT) { const int kb = r / 64, nb = r % 64; c.src = Wout + (size_t)(64 * kb) * DM + 32 * nb; c.ldw = DM; c.dst = WoutT + (size_t)(32 * nb) * DM + 64 * kb; c.K = DM; c.gain = nullptr; return c; } r -= CVT_I_OUT;
    if (r < 2 * CVT_I_G) { const int up = r >= CVT_I_G ? 1 : 0; r -= up * CVT_I_G; const int kb = r / 176, nb = r % 176, n0 = 32 * nb;
        c.src = (up ? Wu : Wg) + (size_t)(64 * kb) * FFN + n0; c.ldw = FFN; c.dst = WguT + (size_t)((n0 >> 7) * 256 + up * 128 + (n0 & 127)) * DM + 64 * kb; c.K = DM; c.gain = gffn + 64 * kb; c.sc = up ? 0.6931471805599453f : 1.4426950408889634f; return c; } r -= 2 * CVT_I_G;
    { const int kb = r / 64, nb = r % 64; c.src = Wd + (size_t)(64 * kb) * DM + 32 * nb; c.ldw = DM; c.dst = WdT + (size_t)(32 * nb) * FFN + 64 * kb; c.K = FFN; c.gain = nullptr; return c; }
}
__device__ __forceinline__ void convert_weights(const Args& a, int l, LAS unsigned char* lds, int it0, int it1, int step, int wave, int lane) {
    asm volatile("" : "+v"(lane));
    LAS float* scr = (LAS float*)(lds + RING_OFF + wave * 16384);
    const int kk = lane >> 3, c4 = (lane & 7) * 4, ch = lane & 7;
    if (it0 >= it1) return;
    CvtItem cur = cvt_decode(a, l, it0); f32x4 v[8];
#define CVT_LOAD(c_) do { const float* s_ = (c_).src + (size_t)kk * (c_).ldw + c4; _Pragma("unroll") for (int i = 0; i < 8; ++i) v[i] = *(const f32x4*)(s_ + (size_t)(8 * i) * (c_).ldw); } while (0)
    CVT_LOAD(cur);
    for (int it = it0; it < it1; it += step) {
#pragma unroll
        for (int i = 0; i < 8; ++i) { LAS float* d = scr + (8 * i + kk) * 33 + c4; d[0] = v[i].x; d[1] = v[i].y; d[2] = v[i].z; d[3] = v[i].w; }
        const CvtItem me = cur;
        if (it + step < it1) { cur = cvt_decode(a, l, it + step); CVT_LOAD(cur); }
        LDS_WAIT(); asm volatile("" ::: "memory");
        f32x4 g0 = (f32x4){1.f, 1.f, 1.f, 1.f}, g1 = g0;
        if (me.gain) { g0 = *(const f32x4*)(me.gain + 8 * ch) * me.sc; g1 = *(const f32x4*)(me.gain + 8 * ch + 4) * me.sc; }
#pragma unroll
        for (int j = 0; j < 4; ++j) { const int n = (lane >> 3) + 8 * j; const LAS float* sp = scr + (8 * ch) * 33 + n;
            v4u o; o.x = cvtpk(sp[0 * 33] * g0.x, sp[1 * 33] * g0.y); o.y = cvtpk(sp[2 * 33] * g0.z, sp[3 * 33] * g0.w); o.z = cvtpk(sp[4 * 33] * g1.x, sp[5 * 33] * g1.y); o.w = cvtpk(sp[6 * 33] * g1.z, sp[7 * 33] * g1.w);
            *(GAS v4u*)(me.dst + (size_t)n * me.K + 8 * ch) = o; }
        LDS_WAIT(); asm volatile("" ::: "memory");
    }
#undef CVT_LOAD
}

template <int KIND>
__device__ __forceinline__ void thin_rows(const float* xin32, bf16* Hn, float* rinv, const bf16* y, const float* g_post, float* xout32, int gw, int NGW, int lane,
                                          const float* wdt_src = nullptr, const float* g_dt = nullptr, float* dtout = nullptr, LAS unsigned char* lds = nullptr) {
    asm volatile("" : "+v"(lane));
    if (wdt_src) { __syncthreads();
        for (int i = threadIdx.x; i < 8 * DM; i += NWAVES * 64) { const int k = i >> 3, n = i & 7; ((LAS float*)lds)[n * DM + k] = wdt_src[(size_t)k * IN_COLS + n] * g_dt[k]; }
        __syncthreads(); }
    f32x4 gp[8];
#pragma unroll
    for (int j = 0; j < 8; ++j) gp[j] = (KIND != 0) ? ((const GAS f32x4*)g_post)[lane + 64 * j] : (f32x4){0.f, 0.f, 0.f, 0.f};
    f32x4 x32A[KIND == 0 ? 8 : 1]; v2u x16A[KIND == 0 ? 1 : 8]; v2u yA[8]; float riA = 1.f;
#define THIN_LOAD(x32, x16, yr, ri, m_) do { \
        if (KIND == 0) { const GAS f32x4* xp_ = (const GAS f32x4*)(xin32 + (size_t)(m_) * DM) + lane; _Pragma("unroll") for (int j = 0; j < 8; ++j) x32[KIND == 0 ? j : 0] = __builtin_nontemporal_load(&xp_[64 * j]); } \
        else { const GAS v2u* xp_ = (const GAS v2u*)(Hn + (size_t)(m_) * DM) + lane; _Pragma("unroll") for (int j = 0; j < 8; ++j) x16[KIND == 0 ? 0 : j] = __builtin_nontemporal_load(&xp_[64 * j]); ri = rinv[m_]; \
               const GAS v2u* yp_ = (const GAS v2u*)(y + (size_t)(m_) * DM) + lane; _Pragma("unroll") for (int j = 0; j < 8; ++j) yr[j] = __builtin_nontemporal_load(&yp_[64 * j]); } } while (0)
#define THIN_ROW(x32, x16, yr, ri) do { \
        f32x4 v[8]; \
        _Pragma("unroll") for (int j = 0; j < 8; ++j) { if (KIND == 0) v[j] = x32[KIND == 0 ? j : 0]; else { const v2u w = x16[KIND == 0 ? 0 : j]; v[j] = (f32x4){bflo(w.x), bfhi(w.x), bflo(w.y), bfhi(w.y)} * ri; } } \
        f32x4 yv[8]; float s = 0.f; \
        if (KIND != 0) { _Pragma("unroll") for (int j = 0; j < 8; ++j) { const v2u w = yr[j]; yv[j] = (f32x4){bflo(w.x), bfhi(w.x), bflo(w.y), bfhi(w.y)}; s += (yv[j].x * yv[j].x + yv[j].y * yv[j].y) + (yv[j].z * yv[j].z + yv[j].w * yv[j].w); } } \
        if (m + NGW < M) THIN_LOAD(x32, x16, yr, ri, m + NGW); \
        if (KIND != 0) { const float r1 = __builtin_amdgcn_rsqf(wave_sum_fast(s) * (1.f / DM) + NORM_EPS); \
            _Pragma("unroll") for (int j = 0; j < 8; ++j) v[j] = v[j] + yv[j] * r1 * gp[j]; } \
        if (KIND == 2) { GAS f32x4* xo = (GAS f32x4*)(xout32 + (size_t)m * DM) + lane; _Pragma("unroll") for (int j = 0; j < 8; ++j) xo[64 * j] = v[j]; } \
        else { float s2 = 0.f; \
            _Pragma("unroll") for (int j = 0; j < 8; ++j) s2 += (v[j].x * v[j].x + v[j].y * v[j].y) + (v[j].z * v[j].z + v[j].w * v[j].w); \
            const float ms = wave_sum_fast(s2) * (1.f / DM) + NORM_EPS; const float r2 = __builtin_amdgcn_rsqf(ms); \
            GAS v2u* ho = (GAS v2u*)(Hn + (size_t)m * DM) + lane; \
            _Pragma("unroll") for (int j = 0; j < 8; ++j) { v[j] = v[j] * r2; v2u w; w.x = cvtpk(v[j].x, v[j].y); w.y = cvtpk(v[j].z, v[j].w); ho[64 * j] = w; } \
            if (lane == 0) rinv[m] = ms * r2; \
            if (wdt_src) { \
                _Pragma("nounroll") for (int n = 0; n < 8; ++n) {          \
                    const LAS f32x4* wp = (const LAS f32x4*)(lds + (size_t)n * DM * 4) + lane; float d = 0.f; \
                    _Pragma("unroll") for (int j = 0; j < 8; ++j) { const f32x4 wv = wp[64 * j]; d += (v[j].x * wv.x + v[j].y * wv.y) + (v[j].z * wv.z + v[j].w * wv.w); } \
                    d = wave_sum_fast(d); if (lane == 0) dtout[(size_t)m * 8 + n] = d; } } } } while (0)
    int m = gw;
    if (m < M) THIN_LOAD(x32A, x16A, yA, riA, m);
    for (; m < M; m += NGW) { THIN_ROW(x32A, x16A, yA, riA); }
#undef THIN_LOAD
#undef THIN_ROW
}

typedef short bf16x8 __attribute__((ext_vector_type(8)));
typedef short s16x4 __attribute__((ext_vector_type(4)));
typedef short v4i16_t __attribute__((ext_vector_type(4)));
typedef float f32x16 __attribute__((ext_vector_type(16)));
typedef LAS const char* lds_cptr;
__device__ __forceinline__ int crow(int r, int hi) { return (r & 3) + 8 * (r >> 2) + 4 * hi; }
__device__ __forceinline__ s16x4 vtr(lds_cptr p) { return __builtin_bit_cast(s16x4, __builtin_amdgcn_ds_read_tr16_b64_v4i16((LAS v4i16_t*)p)); }
__device__ __forceinline__ bf16x8 tr_frag(lds_cptr p, int off2) { const s16x4 lo = vtr(p), hi = vtr(p + off2); return (bf16x8){lo[0], lo[1], lo[2], lo[3], hi[0], hi[1], hi[2], hi[3]}; }
__device__ __forceinline__ bf16x8 pack8(const f32x16& p, int s) { v4u w; w.x = cvtpk(p[8 * s + 0], p[8 * s + 1]); w.y = cvtpk(p[8 * s + 2], p[8 * s + 3]); w.z = cvtpk(p[8 * s + 4], p[8 * s + 5]); w.w = cvtpk(p[8 * s + 6], p[8 * s + 7]); return __builtin_bit_cast(bf16x8, w); }
#define MFMA32(a, b, c) __builtin_amdgcn_mfma_f32_32x32x16_bf16((a), (b), (c), 0, 0, 0)

__device__ __forceinline__ float swap32_max(float v) { auto rr = __builtin_amdgcn_permlane32_swap(__builtin_bit_cast(unsigned, v), __builtin_bit_cast(unsigned, v), false, false); const unsigned r0 = rr[0], r1 = rr[1]; return fmaxf(__builtin_bit_cast(float, r0), __builtin_bit_cast(float, r1)); }
__device__ __forceinline__ float swap32_min(float v) { auto rr = __builtin_amdgcn_permlane32_swap(__builtin_bit_cast(unsigned, v), __builtin_bit_cast(unsigned, v), false, false); const unsigned r0 = rr[0], r1 = rr[1]; return fminf(__builtin_bit_cast(float, r0), __builtin_bit_cast(float, r1)); }
__device__ __forceinline__ float bpermx_f(int src_lane, float v) { return __builtin_bit_cast(float, __builtin_amdgcn_ds_bpermute(src_lane << 2, __builtin_bit_cast(int, v))); }
__device__ __forceinline__ float max3a(float a, float b, float c) { float r; asm("v_max3_f32 %0, %1, %2, %3" : "=v"(r) : "v"(a), "v"(b), "v"(c)); return r; }
__device__ __forceinline__ float max2a(float a, float b) { float r; asm("v_max_f32_e32 %0, %1, %2" : "=v"(r) : "v"(a), "v"(b)); return r; }
__device__ __forceinline__ void kn_unit(const Args& a, int l, int b, int h, int tid) {
    asm volatile("" : "+v"(tid));
    const int lane = tid & 63;
    const bf16* P = (const bf16*)(a.ws + WS_PROJ) + (size_t)b * SEQ * LDP + C_DK + h * 128 + (tid & 15) * 8;
    float mx = 0.f;
    for (int r0 = tid >> 4; r0 < SEQ; r0 += 128) {
        v4u w[4];
#pragma unroll
        for (int i = 0; i < 4; ++i) w[i] = *(const v4u*)(P + (size_t)(r0 + 32 * i) * LDP);
#pragma unroll
        for (int i = 0; i < 4; ++i) { float k2 = 0.f;
#pragma unroll
            for (int k = 0; k < 4; ++k) k2 += bflo(w[i][k]) * bflo(w[i][k]) + bfhi(w[i][k]) * bfhi(w[i][k]);
            k2 += DPP_X1(k2); k2 += DPP_X2(k2); k2 += DPP_HM(k2);
            mx = fmaxf(mx, k2); } }
    mx = fmaxf(mx, SWZ_XORF(mx, 16)); mx = swap32_max(mx);
    unsigned* kn = (unsigned*)(a.ws + WS_CTL) + CW_KN + (size_t)((l * 16 + b * 2 + h) * 2) * 16;
    if (lane == 0 || lane == 8) __hip_atomic_fetch_max(kn + (lane >> 3) * 16, __builtin_bit_cast(unsigned, mx), __ATOMIC_RELAXED, __HIP_MEMORY_SCOPE_AGENT);
    asm volatile("s_waitcnt vmcnt(0)" ::: "memory");
    __syncthreads();
    if (tid == 0) { __builtin_amdgcn_fence(__ATOMIC_RELEASE, "agent"); asm volatile("s_waitcnt vmcnt(0)" ::: "memory");
        __hip_atomic_store((unsigned*)(a.ws + WS_CTL) + CW_KNF + (size_t)(l * 16 + b * 2 + h) * 64, 1u, __ATOMIC_RELAXED, __HIP_MEMORY_SCOPE_AGENT); }
}
__device__ __forceinline__ void diff_unit_mfma(const Args& a, int l, int b, int h, int qb, float lam, float lam_init, LAS unsigned char* lds, int tid) {
    asm volatile("" : "+v"(tid));
    const int lane = tid & 63, wave = __builtin_amdgcn_readfirstlane(tid >> 6), c = wave >> 2, qt = wave & 3, r32 = lane & 31, hi = lane >> 5;
    const int q0 = qb * 128, t = q0 + 32 * qt + r32;
    const bf16* P = (const bf16*)(a.ws + WS_PROJ) + (size_t)b * SEQ * LDP;
    bf16* MIX = (bf16*)(a.ws + WS_MIX) + (size_t)b * SEQ * DM;
    bf16x8 qf[4];
    { const bf16* qrow = P + (size_t)t * LDP + C_DQ + h * 128 + c * 64;
#pragma unroll
      for (int s = 0; s < 4; ++s) qf[s] = *(const bf16x8*)(qrow + 16 * s + 8 * hi); }
    float qn;
    { float q2 = 0.f;
#pragma unroll
      for (int s = 0; s < 4; ++s) { const v4u w = __builtin_bit_cast(v4u, qf[s]);
#pragma unroll
          for (int k = 0; k < 4; ++k) q2 += bflo(w[k]) * bflo(w[k]) + bfhi(w[k]) * bfhi(w[k]); }
      q2 = swap32_sum(q2);
      q2 = fmaxf(q2, DPP_X1(q2)); q2 = fmaxf(q2, DPP_X2(q2)); q2 = fmaxf(q2, DPP_HM(q2)); q2 = fmaxf(q2, DPP_RM(q2)); q2 = fmaxf(q2, SWZ_XORF(q2, 16));
      qn = sqrtf(q2) * 1.001f; }
    const float s8 = 8.f * exp2f(-2.f * (float)(h + 1));
    typedef float f32x2p __attribute__((ext_vector_type(2)));
    f32x16 CR;
#pragma unroll
    for (int r = 0; r < 16; ++r) CR[r] = s8 * (float)crow(r, hi);
    const float base_l = -s8 * (float)t;
    constexpr float c1 = 0.125f * 1.4426950408889634f;
    f32x16 O[4];
#pragma unroll
    for (int e = 0; e < 4; ++e)
#pragma unroll
        for (int r = 0; r < 16; ++r) O[e][r] = 0.f;
    float m = -1e30f, lsum = 0.f;
    float mfloor = -1e30f; int nproc = 0;
    const int NT = 2 * qb + 2;
    constexpr int KROW = 144, VROW = 64, VTILE = 64 * VROW, KBYTES = 64 * KROW, VOFF = 2 * KBYTES, BUFB = VOFF + 4 * VTILE;
    v4u pre[4], pre2[4];
    const bf16* gsrc[4]; int ldst[4];
#pragma unroll
    for (int i = 0; i < 4; ++i) { const int idx = tid + 512 * i;
        if (i < 2) { const int cc = idx >> 9, key = (idx >> 3) & 63, ch = idx & 7; gsrc[i] = P + (size_t)key * LDP + C_DK + h * 128 + cc * 64 + ch * 8; ldst[i] = cc * KBYTES + key * KROW + ch * 16; }
        else { const int j = idx - 1024, key = j >> 4, ch = j & 15; gsrc[i] = P + (size_t)key * LDP + C_DV + h * 128 + ch * 8; ldst[i] = VOFF + (ch >> 2) * VTILE + key * VROW + (ch & 3) * 16; } }
#define DIFF_LOAD(dst, kt) do { _Pragma("unroll") for (int i = 0; i < 4; ++i) dst[i] = *(const v4u*)(gsrc[i] + (size_t)(kt) * 64 * LDP); } while (0)
#define DIFF_WRITE(pre, buf) do { _Pragma("unroll") for (int i = 0; i < 4; ++i) *(LAS v4u*)(lds + (buf) * BUFB + ldst[i]) = pre[i]; \
        if (h < 2) _Pragma("unroll") for (int i = 0; i < 2; ++i) { float k2 = 0.f; _Pragma("unroll") for (int k = 0; k < 4; ++k) k2 += bflo(pre[i][k]) * bflo(pre[i][k]) + bfhi(pre[i][k]) * bfhi(pre[i][k]); \
            k2 += DPP_X1(k2); k2 += DPP_X2(k2); k2 += DPP_HM(k2); k2 = fmaxf(k2, DPP_RM(k2)); \
            if ((lane & 15) == 0) KN2[((buf) * 2 + i) * 32 + wave * 4 + (lane >> 4)] = k2; } } while (0)
    LAS float* KN2 = (LAS float*)(lds + 2 * BUFB);
    volatile LAS int* EX = (volatile LAS int*)(lds + 2 * BUFB + 512);
    if (h < 2 && tid == 0) { unsigned* knf = (unsigned*)(a.ws + WS_CTL) + CW_KNF + (size_t)(l * 16 + b * 2 + h) * 64; unsigned sp = 0;
        while (__hip_atomic_load(knf, __ATOMIC_RELAXED, __HIP_MEMORY_SCOPE_AGENT) == 0u) { __builtin_amdgcn_s_sleep(2); if (++sp > (1u << 22)) break; }
        __builtin_amdgcn_fence(__ATOMIC_ACQUIRE, "agent"); asm volatile("s_waitcnt vmcnt(0)" ::: "memory"); }
    const int kfoff = c * KBYTES + r32 * KROW + 16 * hi;
    const int vfoff = VOFF + (4 * hi + ((lane & 15) >> 2)) * VROW + (16 * ((lane >> 4) & 1) + 4 * (lane & 3)) * 2;
    DIFF_LOAD(pre, NT - 1); DIFF_WRITE(pre, 0);
    DIFF_LOAD(pre, NT - 2);
    __syncthreads();
    float knb = 0.f;
    if (h < 2) knb = sqrtf(__builtin_bit_cast(float, __hip_atomic_load((unsigned*)(a.ws + WS_CTL) + CW_KN + (size_t)((l * 16 + b * 2 + h) * 2 + c) * 16, __ATOMIC_RELAXED, __HIP_MEMORY_SCOPE_AGENT))) * 1.001f;
    int buf = 0;
    for (int kt2 = NT - 1; kt2 >= 1; kt2 -= 2) {
#pragma unroll
    for (int par = 0; par < 2; ++par) { const int kt = kt2 - par;
        if (kt > 1) { if (par == 0) DIFF_LOAD(pre2, kt - 2); else DIFF_LOAD(pre, kt - 2); }
        const int kbase = kt * 64;
        bool live = kbase <= q0 + 32 * qt + 31;
        { const int dmin = (q0 + 32 * qt) - (kbase + 63);
          if (h < 2 && dmin > 0 && nproc >= 2) {
              const LAS f32x4* kp = (const LAS f32x4*)(KN2 + (buf * 2 + c) * 32); f32x4 k4 = kp[0];
#pragma unroll
              for (int w8 = 1; w8 < 8; ++w8) { const f32x4 t4 = kp[w8]; k4.x = fmaxf(k4.x, t4.x); k4.y = fmaxf(k4.y, t4.y); k4.z = fmaxf(k4.z, t4.z); k4.w = fmaxf(k4.w, t4.w); }
              const float kn2 = fmaxf(fmaxf(k4.x, k4.y), fmaxf(k4.z, k4.w));
              const float ub = qn * sqrtf(kn2) * 1.001f - s8 * (float)dmin;
              if ((ub - mfloor) * c1 < -40.f) live = false; } }
        if (live) {
            lds_cptr kb = (lds_cptr)(lds + buf * BUFB + kfoff); lds_cptr vb = (lds_cptr)(lds + buf * BUFB + vfoff);
            f32x16 S0, S1;
            bf16x8 kf[8];
#pragma unroll
            for (int s = 0; s < 4; ++s) { kf[2 * s] = *(const LAS bf16x8*)(kb + 32 * s); kf[2 * s + 1] = *(const LAS bf16x8*)(kb + 32 * KROW + 32 * s); }
            const float off0 = s8 * (float)kbase + base_l, off1 = off0 + s8 * 32.f;
            __builtin_amdgcn_sched_barrier(0);
            S0 = MFMA32(kf[0], qf[0], CR); S1 = MFMA32(kf[1], qf[0], CR);
#pragma unroll
            for (int s = 1; s < 4; ++s) { S0 = MFMA32(kf[2 * s], qf[s], S0); S1 = MFMA32(kf[2 * s + 1], qf[s], S1); }
            asm volatile("s_nop 15\n\ts_nop 7" : "+v"(S0), "+v"(S1));
            if (kt >= NT - 2) {
#pragma unroll
                for (int r = 0; r < 16; ++r) { const int key = kbase + crow(r, hi); if (key > t) S0[r] = -1e30f; if (key + 32 > t) S1[r] = -1e30f; } }
            float mt0 = max2a(S0[0], S0[1]), mt1 = max2a(S1[0], S1[1]);
#pragma unroll
            for (int r = 2; r < 16; r += 2) { mt0 = max3a(mt0, S0[r], S0[r + 1]); mt1 = max3a(mt1, S1[r], S1[r + 1]); }
            float mt = fmaxf(mt0 + off0, mt1 + off1);
            mt = swap32_max(mt);
            if (!__all((mt - m) * c1 < -40.f)) {
            const float mn = max2a(m, mt);
            if (__any(mn > m)) { const float al = __builtin_amdgcn_exp2f((m - mn) * c1); lsum *= al;
#pragma unroll
                for (int e = 0; e < 4; ++e)
#pragma unroll
                    for (int r = 0; r < 16; ++r) O[e][r] *= al;
                m = mn; }
            const float mc0 = (off0 - m) * c1, mc1 = (off1 - m) * c1; const f32x2p c1v = (f32x2p){c1, c1}, mcv0 = (f32x2p){mc0, mc0}, mcv1 = (f32x2p){mc1, mc1}; f32x2p psv = (f32x2p){0.f, 0.f};
#pragma unroll
            for (int i = 0; i < 8; ++i) { f32x2p a0 = (f32x2p){S0[2 * i], S0[2 * i + 1]} * c1v + mcv0, a1 = (f32x2p){S1[2 * i], S1[2 * i + 1]} * c1v + mcv1;
                a0.x = __builtin_amdgcn_exp2f(a0.x); a0.y = __builtin_amdgcn_exp2f(a0.y); a1.x = __builtin_amdgcn_exp2f(a1.x); a1.y = __builtin_amdgcn_exp2f(a1.y);
                S0[2 * i] = a0.x; S0[2 * i + 1] = a0.y; S1[2 * i] = a1.x; S1[2 * i + 1] = a1.y; psv += a0 + a1; }
            lsum += psv.x + psv.y;
            bf16x8 pf[4]; pf[0] = pack8(S0, 0); pf[1] = pack8(S0, 1); pf[2] = pack8(S1, 0); pf[3] = pack8(S1, 1);
#pragma unroll
            for (int k16 = 0; k16 < 4; ++k16)
#pragma unroll
                for (int e = 0; e < 4; ++e) { const bf16x8 vf = tr_frag(vb + 16 * k16 * VROW + e * VTILE, 8 * VROW); O[e] = MFMA32(vf, pf[k16], O[e]); }
            }
            ++nproc;
            if (nproc == 2 || nproc == 6) { float mm = swap32_min(m); mm = fminf(mm, DPP_X1(mm)); mm = fminf(mm, DPP_X2(mm)); mm = fminf(mm, DPP_HM(mm)); mm = fminf(mm, DPP_RM(mm)); mm = fminf(mm, SWZ_XORF(mm, 16)); mfloor = mm; }
        }
        if (kt > 0) { if (par == 0) DIFF_WRITE(pre, buf ^ 1); else DIFF_WRITE(pre2, buf ^ 1); }
        if (h < 2 && kt > 0) {
            const int dminn = (q0 + 32 * qt) - ((kt - 1) * 64 + 63);
            const bool dn = nproc >= 2 && dminn > 0 && ((qn * knb - s8 * (float)dminn - mfloor) * c1 < -40.f);
            if (lane == 0) EX[(kt & 1) * 8 + wave] = dn ? 1 : 0; }
        __syncthreads();
        buf ^= 1;
        if (h < 2 && kt > 0) { int alld = 1;
#pragma unroll
            for (int w8 = 0; w8 < 8; ++w8) alld &= EX[(kt & 1) * 8 + w8];
            if (alld) goto diff_done; }
    } }
diff_done:
#undef DIFF_LOAD
#undef DIFF_WRITE
    lsum = swap32_sum(lsum);
    const float il = 1.f / lsum;
    LAS float* X = (LAS float*)lds;
    if (c == 1) {
#pragma unroll
        for (int e = 0; e < 4; ++e)
#pragma unroll
            for (int r = 0; r < 16; ++r) X[(qt * 64 + e * 16 + r) * 64 + lane] = O[e][r] * il; }
    __syncthreads();
    if (c == 0) {
        float ss = 0.f;
#pragma unroll
        for (int e = 0; e < 4; ++e)
#pragma unroll
            for (int r = 0; r < 16; ++r) { const float v = O[e][r] * il - lam * X[(qt * 64 + e * 16 + r) * 64 + lane]; O[e][r] = v; ss += v * v; }
        ss += __shfl_xor(ss, 32);
        const float rn = (1.f - lam_init) / sqrtf(ss * (1.f / 128.f) + NORM_EPS);
        const float* gain = a.in[11] + l * 128;
        bf16* orow = MIX + (size_t)t * DM + 1024 + h * 128;
#pragma unroll
        for (int e = 0; e < 4; ++e)
#pragma unroll
            for (int rg = 0; rg < 4; ++rg) { const int e0 = 32 * e + 8 * rg + 4 * hi; const f32x4 g = *(const f32x4*)(gain + e0);
                v2u w; w.x = cvtpk(O[e][4 * rg + 0] * rn * g.x, O[e][4 * rg + 1] * rn * g.y); w.y = cvtpk(O[e][4 * rg + 2] * rn * g.z, O[e][4 * rg + 3] * rn * g.w);
                *(v2u*)(orow + e0) = w; }
    }
}


#define SWZ_XOR(v, k) __builtin_bit_cast(float, __builtin_amdgcn_ds_swizzle(__builtin_bit_cast(int, (float)(v)), ((k) << 10) | 0x1f))
__device__ __forceinline__ float bperm_f(int src_lane, float v) { return __builtin_bit_cast(float, __builtin_amdgcn_ds_bpermute(src_lane << 2, __builtin_bit_cast(int, v))); }
__device__ __forceinline__ float silu_fast(float x) { return x * __builtin_amdgcn_rcpf(1.0f + __builtin_amdgcn_exp2f(-1.4426950408889634f * x)); }
__device__ __forceinline__ float exp_fast(float x) { return __builtin_amdgcn_exp2f(1.4426950408889634f * x); }
template <int MODE>
__device__ __forceinline__ void ssd_unit_mfma(const Args& a, int l, int b, int g, int seg, LAS unsigned char* lds, int tid) {
    asm volatile("" : "+v"(tid));
    constexpr int CH = 64, BROW = 272, XROW = 528;
    constexpr int OFF_B = 0, OFF_C = OFF_B + CH * BROW, OFF_X = OFF_C + CH * BROW, OFF_Y = OFF_X + CH * XROW, OFF_T = OFF_Y + CH * XROW, OFF_W = OFF_T + 3072;
    const int wave = __builtin_amdgcn_readfirstlane(tid >> 6);
    const int hr = wave >> 1, pt = wave & 1;
    LAS float* dtT = (LAS float*)(lds + OFF_T); LAS float* acT = dtT + CH * 4; LAS float* wT = acT + CH * 4;
    const bf16* P = (const bf16*)(a.ws + WS_PROJ) + (size_t)b * SEQ * LDP;
    bf16* MIX = (bf16*)(a.ws + WS_MIX) + (size_t)b * SEQ * DM;
    { const int c = tid; const int cc = c < 256 ? g * 256 + c : (c < 384 ? 512 + g * 128 + (c - 256) : 768 + g * 128 + (c - 384));
      const f32x4 w = *(const f32x4*)(a.in[4] + (size_t)l * 4096 + cc * 4); const float bb = a.in[5][l * 1024 + cc];
      *(LAS f32x4*)(lds + OFF_W + c * 32) = w; *(LAS float*)(lds + OFF_W + c * 32 + 16) = bb; }
    const float* dtb = a.in[6] + l * 8 + g * 4; const float* alog = a.in[7] + l * 8 + g * 4; const float* dsk = a.in[8] + l * 8 + g * 4;
    const float* ngain = a.in[9] + l * 512 + g * 256;
    f32x16 H[4];
#pragma unroll
    for (int n = 0; n < 4; ++n)
#pragma unroll
        for (int r = 0; r < 16; ++r) H[n][r] = 0.f;
    constexpr int SEGT = 512;
    const int tbeg = seg * SEGT, tend = tbeg + SEGT;
    const int unit16 = b * 2 + g;
    float* SL = (float*)((unsigned char*)a.out + OS_SSDS); float* SD = (float*)((unsigned char*)a.out + OS_SSDL); unsigned* flags = (unsigned*)(a.ws + WS_CTL) + CW_FLAG + (size_t)((l * 16 + unit16) * 8) * 64;
    float lsum = 0.f;
    v4u raw[11]; float dtraw = 0.f;
#define SSD_PREFETCH(t0n) do { int tl_ = tid; asm volatile("" : "+v"(tl_)); const int cg_ = tl_ & 63; \
        const int col_ = C_SXBC + (cg_ < 32 ? g * 256 + 8 * cg_ : (cg_ < 48 ? 512 + g * 128 + 8 * (cg_ - 32) : 768 + g * 128 + 8 * (cg_ - 48))); \
        _Pragma("unroll") for (int i_ = 0; i_ < 11; ++i_) { const int row_ = (t0n) + 8 * wave - 3 + i_; \
            raw[i_] = (row_ >= 0) ? *(const v4u*)(P + (size_t)row_ * LDP + col_) : (v4u){0u, 0u, 0u, 0u}; } \
        if (wave < 4) dtraw = ((const float*)(a.ws + WS_DT))[((size_t)b * SEQ + (t0n) + cg_) * 8 + g * 4 + wave]; } while (0)
    SSD_PREFETCH(tbeg);
    if (MODE == 1 && seg > 0) {
        if (tid == 0) { for (int j = 0; j < seg; ++j) { unsigned sp = 0; while (__hip_atomic_load(flags + j * 64, __ATOMIC_RELAXED, __HIP_MEMORY_SCOPE_AGENT) == 0u) { __builtin_amdgcn_s_sleep(2); if (++sp > (1u << 22)) break; } }
            __builtin_amdgcn_fence(__ATOMIC_ACQUIRE, "agent"); asm volatile("s_waitcnt vmcnt(0)" ::: "memory"); }
        __syncthreads();
        { int tl = tid; asm volatile("" : "+v"(tl)); const int lane = tl & 63;
          float cum = 0.f;
          for (int j = seg - 1; j >= 0; --j) { const float f = exp_fast(cum);
              const float* src = SL + ((size_t)((unit16 * 8 + j) * 8 + wave) * 16) * 256 + lane * 4;
#pragma unroll
              for (int n = 0; n < 4; ++n)
#pragma unroll
                  for (int rq = 0; rq < 4; ++rq) { const f32x4 v = *(const f32x4*)(src + (n * 4 + rq) * 256);
                      H[n][4 * rq + 0] += f * v.x; H[n][4 * rq + 1] += f * v.y; H[n][4 * rq + 2] += f * v.z; H[n][4 * rq + 3] += f * v.w; }
              cum += SD[(unit16 * 8 + j) * 4 + hr]; } }
    }
    __syncthreads();
    for (int t0 = tbeg; t0 < tend; t0 += CH) {
        { int tl = tid; asm volatile("" : "+v"(tl)); const int cg = tl & 63, lane = cg;
          const int dst = (cg < 32 ? OFF_X + cg * 16 : (cg < 48 ? OFF_B + (cg - 32) * 16 : OFF_C + (cg - 48) * 16));
          const int dstride = cg < 32 ? XROW : BROW;
#pragma unroll
          for (int hf = 0; hf < 2; ++hf) {
              f32x4 wv[4]; float bv[4];
#pragma unroll
              for (int c = 0; c < 4; ++c) { wv[c] = *(const LAS f32x4*)(lds + OFF_W + (8 * cg + 4 * hf + c) * 32); bv[c] = *(const LAS float*)(lds + OFF_W + (8 * cg + 4 * hf + c) * 32 + 16); }
              float xw[4][4];
#pragma unroll
              for (int k = 0; k < 3; ++k)
#pragma unroll
                  for (int j = 0; j < 2; ++j) { xw[k][2 * j] = bflo(raw[k][2 * hf + j]); xw[k][2 * j + 1] = bfhi(raw[k][2 * hf + j]); }
#pragma unroll
              for (int i = 0; i < 8; ++i) {
#pragma unroll
                  for (int j = 0; j < 2; ++j) { xw[(i + 3) & 3][2 * j] = bflo(raw[i + 3][2 * hf + j]); xw[(i + 3) & 3][2 * j + 1] = bfhi(raw[i + 3][2 * hf + j]); }
                  float o[4];
#pragma unroll
                  for (int c = 0; c < 4; ++c) { const float cv = bv[c] + wv[c].x * xw[i & 3][c] + wv[c].y * xw[(i + 1) & 3][c] + wv[c].z * xw[(i + 2) & 3][c] + wv[c].w * xw[(i + 3) & 3][c]; o[c] = silu_fast(cv); }
                  v2u w; w.x = cvtpk(o[0], o[1]); w.y = cvtpk(o[2], o[3]);
                  *(LAS v2u*)(lds + dst + 8 * hf + (8 * wave + i) * dstride) = w;
                  __builtin_amdgcn_sched_barrier(0); }
              asm volatile("" ::: "memory");
          }
          if (wave < 4) { const int r = wave;
              const float xv = dtraw + dtb[r];
              const float dtv = xv > 20.f ? xv : log1pf(__expf(xv));
              float ac = dtv * (-__expf(alog[r]));
#pragma unroll
              for (int off = 1; off < 64; off <<= 1) { const float o = bperm_f(lane - off, ac); if (lane >= off) ac += o; }
              const float tot = bperm_f(63, ac);
              lsum += tot;
              dtT[lane * 4 + r] = dtv; acT[lane * 4 + r] = ac; wT[lane * 4 + r] = dtv * exp_fast(tot - ac); } }
        if (MODE == 0 && t0 + CH < tend) SSD_PREFETCH(t0 + CH);
        __syncthreads();
        v4u zr[4];
        if (MODE == 1) { int tl = tid; asm volatile("" : "+v"(tl)); const int tt = tl >> 3, c0 = (tl & 7) * 32;
#pragma unroll
          for (int i = 0; i < 4; ++i) zr[i] = *(const v4u*)(P + (size_t)(t0 + tt) * LDP + C_SZ + g * 256 + c0 + 8 * i); }
        {
            int tl = tid; asm volatile("" : "+v"(tl)); const int lane = tl & 63, r32 = lane & 31, hi = lane >> 5, trq = (lane & 15) >> 2;
            const int chcol = (hr * 64 + pt * 32 + 16 * ((lane >> 4) & 1) + 4 * (lane & 3)) * 2;
            lds_cptr Bi = (lds_cptr)(lds + OFF_B), Ci = (lds_cptr)(lds + OFF_C), Xi = (lds_cptr)(lds + OFF_X);
            f32x16 Y[2];
            if (MODE == 1) {
#pragma unroll
            for (int li = 0; li < 2; ++li) {
                f32x16 acc;
#pragma unroll
                for (int r = 0; r < 16; ++r) acc[r] = 0.f;
#pragma unroll
                for (int n = 0; n < 4; ++n)
#pragma unroll
                    for (int s = 0; s < 2; ++s) { lds_cptr cp = Ci + (32 * li + r32) * BROW + (32 * n + 16 * s + 4 * hi) * 2;
                        const s16x4 lo = *(const LAS s16x4*)cp, h4 = *(const LAS s16x4*)(cp + 16);
                        const bf16x8 af = (bf16x8){lo[0], lo[1], lo[2], lo[3], h4[0], h4[1], h4[2], h4[3]};
                        acc = MFMA32(af, pack8(H[n], s), acc); }
#pragma unroll
                for (int r = 0; r < 16; ++r) Y[li][r] = acc[r] * exp_fast(acT[(32 * li + crow(r, hi)) * 4 + hr]);
                __builtin_amdgcn_sched_barrier(0);
            }
#pragma unroll
            for (int tix = 0; tix < 3; ++tix) { const int sj = tix >> 1, li = (tix + 1) >> 1;
                f32x16 cb;
#pragma unroll
                for (int r = 0; r < 16; ++r) cb[r] = 0.f;
#pragma unroll
                for (int kn = 0; kn < 8; ++kn) { const bf16x8 af = *(const LAS bf16x8*)(Bi + (32 * sj + r32) * BROW + (16 * kn + 8 * hi) * 2);
                    const bf16x8 bfr = *(const LAS bf16x8*)(Ci + (32 * li + r32) * BROW + (16 * kn + 8 * hi) * 2);
                    cb = MFMA32(af, bfr, cb); }
                const int lq = 32 * li + r32; const float acl = acT[lq * 4 + hr];
#pragma unroll
                for (int r = 0; r < 16; ++r) { const int sk = 32 * sj + crow(r, hi);
                    const float d = exp_fast(fminf(acl - acT[sk * 4 + hr], 0.f)) * dtT[sk * 4 + hr];
                    cb[r] = (sk <= lq) ? cb[r] * d : 0.f; }
#pragma unroll
                for (int ks = 0; ks < 2; ++ks) { const bf16x8 pa = pack8(cb, ks);
                    const bf16x8 xb = tr_frag(Xi + (32 * sj + 16 * ks + 4 * hi + trq) * XROW + chcol, 8 * XROW);
                    Y[li] = MFMA32(pa, xb, Y[li]); }
                __builtin_amdgcn_sched_barrier(0);
            }
#pragma unroll
            for (int li = 0; li < 2; ++li)
#pragma unroll
                for (int r = 0; r < 16; ++r) *(LAS bf16*)(lds + OFF_Y + (32 * li + crow(r, hi)) * XROW + (hr * 64 + pt * 32 + r32) * 2) = (bf16)cvtpk1(Y[li][r]);
            }
            { const float dec = exp_fast(acT[63 * 4 + hr]);
#pragma unroll
              for (int n = 0; n < 4; ++n)
#pragma unroll
                  for (int r = 0; r < 16; ++r) H[n][r] *= dec; }
            __builtin_amdgcn_sched_barrier(0);
#pragma unroll
            for (int ks = 0; ks < 4; ++ks) {
                const bf16x8 xr = tr_frag(Xi + (16 * ks + 8 * hi + trq) * XROW + chcol, 4 * XROW);
                const v4u xw = __builtin_bit_cast(v4u, xr); v4u sw;
#pragma unroll
                for (int j = 0; j < 4; ++j) { const float wa = wT[(16 * ks + 8 * hi + 2 * j) * 4 + hr], wb = wT[(16 * ks + 8 * hi + 2 * j + 1) * 4 + hr];
                    sw[j] = cvtpk(bflo(xw[j]) * wa, bfhi(xw[j]) * wb); }
                const bf16x8 xs = __builtin_bit_cast(bf16x8, sw);
#pragma unroll
                for (int n = 0; n < 4; ++n) { const bf16x8 ab = tr_frag(Bi + (16 * ks + 8 * hi + trq) * BROW + (32 * n + 16 * ((lane >> 4) & 1) + 4 * (lane & 3)) * 2, 4 * BROW);
                    H[n] = MFMA32(ab, xs, H[n]); }
                __builtin_amdgcn_sched_barrier(0);
            }
        }
        __syncthreads();
        if (MODE == 1 && t0 + CH < tend) SSD_PREFETCH(t0 + CH);
        if (MODE == 1) { int tl = tid; asm volatile("" : "+v"(tl)); const int tt = tl >> 3, c0 = (tl & 7) * 32; const int t = t0 + tt;
          float y[32]; float ss = 0.f; const float dk = dsk[c0 >> 6];
#pragma unroll
          for (int i = 0; i < 4; ++i) { const v4u yw = *(const LAS v4u*)(lds + OFF_Y + tt * XROW + (c0 + 8 * i) * 2); const v4u xw = *(const LAS v4u*)(lds + OFF_X + tt * XROW + (c0 + 8 * i) * 2);
              const v4u zw = zr[i];
#pragma unroll
              for (int k = 0; k < 4; ++k) { const float ya = (bflo(yw[k]) + bflo(xw[k]) * dk) * silu_fast(bflo(zw[k])), yb = (bfhi(yw[k]) + bfhi(xw[k]) * dk) * silu_fast(bfhi(zw[k]));
                  y[8 * i + 2 * k] = ya; y[8 * i + 2 * k + 1] = yb; ss += ya * ya + yb * yb; } }
          ss += SWZ_XOR(ss, 1); ss += SWZ_XOR(ss, 2); ss += SWZ_XOR(ss, 4);
          const float rn = __builtin_amdgcn_rsqf(ss * (1.f / 256.f) + NORM_EPS);
#pragma unroll
          for (int i = 0; i < 4; ++i) { const f32x4 g0 = *(const f32x4*)(ngain + c0 + 8 * i), g1 = *(const f32x4*)(ngain + c0 + 8 * i + 4);
              v4u w; w.x = cvtpk(y[8 * i + 0] * rn * g0.x, y[8 * i + 1] * rn * g0.y); w.y = cvtpk(y[8 * i + 2] * rn * g0.z, y[8 * i + 3] * rn * g0.w);
              w.z = cvtpk(y[8 * i + 4] * rn * g1.x, y[8 * i + 5] * rn * g1.y); w.w = cvtpk(y[8 * i + 6] * rn * g1.z, y[8 * i + 7] * rn * g1.w);
              *(v4u*)(MIX + (size_t)t * DM + 512 + g * 256 + c0 + 8 * i) = w; } }
        if (MODE == 1) __syncthreads();
    }
#undef SSD_PREFETCH
    if (MODE == 0) {
        { int tl = tid; asm volatile("" : "+v"(tl)); const int lane = tl & 63;
          float* dst = SL + ((size_t)((unit16 * 8 + seg) * 8 + wave) * 16) * 256 + lane * 4;
#pragma unroll
          for (int n = 0; n < 4; ++n)
#pragma unroll
              for (int rq = 0; rq < 4; ++rq) *(f32x4*)(dst + (n * 4 + rq) * 256) = (f32x4){H[n][4 * rq + 0], H[n][4 * rq + 1], H[n][4 * rq + 2], H[n][4 * rq + 3]};
          if (wave < 4 && lane == 0) SD[(unit16 * 8 + seg) * 4 + wave] = lsum; }
        asm volatile("s_waitcnt vmcnt(0)" ::: "memory");
        __syncthreads();
        if (tid == 0) { __builtin_amdgcn_fence(__ATOMIC_RELEASE, "agent"); asm volatile("s_waitcnt vmcnt(0)" ::: "memory");
            __hip_atomic_store(flags + seg * 64, 1u, __ATOMIC_RELAXED, __HIP_MEMORY_SCOPE_AGENT); }
    }
}


template <int MODE>
__device__ __forceinline__ void ret_unit_mfma(const Args& a, int l, int b, int h, int seg, LAS unsigned char* lds, int tid) {
    asm volatile("" : "+v"(tid));
    constexpr int CH = 64, KROW = 144, VROW = 272, SEGT = 512;
    constexpr int OFF_K = 0, OFF_Q = OFF_K + CH * KROW, OFF_V = OFF_Q + CH * KROW, OFF_Y = OFF_V + CH * VROW;
    const int wave = __builtin_amdgcn_readfirstlane(tid >> 6), et = wave & 3, qh = wave >> 2;
    const float gl = log2f(1.f - exp2f(-5.f - (float)h));
    const float g64 = exp2f(64.f * gl);
    const bf16* P = (const bf16*)(a.ws + WS_PROJ) + (size_t)b * SEQ * LDP;
    bf16* MIX = (bf16*)(a.ws + WS_MIX) + (size_t)b * SEQ * DM;
    const float* gain = a.in[3] + l * 512 + h * 128;
    const int tbeg = seg * SEGT, tend = tbeg + SEGT, unit32 = b * 4 + h;
    float* RS = (float*)((unsigned char*)a.out + OS_RETS); unsigned* flags = (unsigned*)(a.ws + WS_CTL) + CW_FLAG2 + (size_t)((l * 32 + unit32) * 8) * 64;
    f32x16 Hs[2];
#pragma unroll
    for (int d = 0; d < 2; ++d)
#pragma unroll
        for (int r = 0; r < 16; ++r) Hs[d][r] = 0.f;
    v4u pre[4];
#define RET_PREFETCH(t0n) do { int tl_ = tid; asm volatile("" : "+v"(tl_)); \
        pre[0] = *(const v4u*)(P + (size_t)((t0n) + (tl_ >> 3)) * LDP + C_RK + h * 64 + (tl_ & 7) * 8); \
        if (MODE == 1) pre[1] = *(const v4u*)(P + (size_t)((t0n) + (tl_ >> 3)) * LDP + C_RQ + h * 64 + (tl_ & 7) * 8); \
        pre[2] = *(const v4u*)(P + (size_t)((t0n) + (tl_ >> 4)) * LDP + C_RV + h * 128 + (tl_ & 15) * 8); \
        pre[3] = *(const v4u*)(P + (size_t)((t0n) + 32 + (tl_ >> 4)) * LDP + C_RV + h * 128 + (tl_ & 15) * 8); } while (0)
    RET_PREFETCH(tbeg);
    if (MODE == 1 && seg > 0) {
        if (tid == 0) { for (int j = 0; j < seg; ++j) { unsigned sp = 0; while (__hip_atomic_load(flags + j * 64, __ATOMIC_RELAXED, __HIP_MEMORY_SCOPE_AGENT) == 0u) { __builtin_amdgcn_s_sleep(2); if (++sp > (1u << 22)) break; } }
            __builtin_amdgcn_fence(__ATOMIC_ACQUIRE, "agent"); asm volatile("s_waitcnt vmcnt(0)" ::: "memory"); }
        __syncthreads();
        { int tl = tid; asm volatile("" : "+v"(tl)); const int lane = tl & 63;
          for (int j = 0; j < seg; ++j) { const float f = exp2f(gl * (float)(SEGT * (seg - 1 - j)));
              const float* src = RS + ((size_t)((unit32 * 8 + j) * 4 + et) * 8) * 256 + lane * 4;
#pragma unroll
              for (int d = 0; d < 2; ++d)
#pragma unroll
                  for (int rq = 0; rq < 4; ++rq) { const f32x4 v = *(const f32x4*)(src + (d * 4 + rq) * 256);
                      Hs[d][4 * rq + 0] += f * v.x; Hs[d][4 * rq + 1] += f * v.y; Hs[d][4 * rq + 2] += f * v.z; Hs[d][4 * rq + 3] += f * v.w; } } }
    }
    for (int t0 = tbeg; t0 < tend; t0 += CH) {
        { int tl = tid; asm volatile("" : "+v"(tl));
          { const int row = tl >> 3, ch = tl & 7; const v4u w = pre[0]; const float f = 0.125f * __builtin_amdgcn_exp2f(-gl * (float)row);
            v4u o; o.x = cvtpk(bflo(w.x) * f, bfhi(w.x) * f); o.y = cvtpk(bflo(w.y) * f, bfhi(w.y) * f); o.z = cvtpk(bflo(w.z) * f, bfhi(w.z) * f); o.w = cvtpk(bflo(w.w) * f, bfhi(w.w) * f);
            *(LAS v4u*)(lds + OFF_K + row * KROW + ch * 16) = o;
            if (MODE == 1) *(LAS v4u*)(lds + OFF_Q + row * KROW + ch * 16) = pre[1]; }
          { const int row = tl >> 4, ch = tl & 15; *(LAS v4u*)(lds + OFF_V + row * VROW + ch * 16) = pre[2]; *(LAS v4u*)(lds + OFF_V + (32 + row) * VROW + ch * 16) = pre[3]; } }
        __syncthreads();
        if (t0 + CH < tend) RET_PREFETCH(t0 + CH);
        v4u gz[2];
        if (MODE == 1) { int tl = tid; asm volatile("" : "+v"(tl)); const int tt = tl >> 3, e0 = (tl & 7) * 16;
            gz[0] = *(const v4u*)(P + (size_t)(t0 + tt) * LDP + C_RG + h * 128 + e0); gz[1] = *(const v4u*)(P + (size_t)(t0 + tt) * LDP + C_RG + h * 128 + e0 + 8); }
        { int tl = tid; asm volatile("" : "+v"(tl)); const int lane = tl & 63, r32 = lane & 31, hi = lane >> 5, trq = (lane & 15) >> 2;
          const int trc = (16 * ((lane >> 4) & 1) + 4 * (lane & 3)) * 2;
          lds_cptr Ki = (lds_cptr)(lds + OFF_K), Qi = (lds_cptr)(lds + OFF_Q), Vi = (lds_cptr)(lds + OFF_V);
          if (MODE == 1) {
          f32x16 Y;
#pragma unroll
          for (int r = 0; r < 16; ++r) Y[r] = 0.f;
#pragma unroll
          for (int d = 0; d < 2; ++d)
#pragma unroll
              for (int s = 0; s < 2; ++s) { lds_cptr qp = Qi + (32 * qh + r32) * KROW + (32 * d + 16 * s + 4 * hi) * 2;
                  const s16x4 lo = *(const LAS s16x4*)qp, h4 = *(const LAS s16x4*)(qp + 16);
                  const bf16x8 af = (bf16x8){lo[0], lo[1], lo[2], lo[3], h4[0], h4[1], h4[2], h4[3]};
                  Y = MFMA32(af, pack8(Hs[d], s), Y); }
#pragma unroll
          for (int r = 0; r < 16; ++r) Y[r] *= g64;
          for (int sj = 0; sj <= qh; ++sj) {
              f32x16 S;
#pragma unroll
              for (int r = 0; r < 16; ++r) S[r] = 0.f;
#pragma unroll
              for (int kd = 0; kd < 4; ++kd) { const bf16x8 af = *(const LAS bf16x8*)(Ki + (32 * sj + r32) * KROW + (16 * kd + 8 * hi) * 2);
                  const bf16x8 bfr = *(const LAS bf16x8*)(Qi + (32 * qh + r32) * KROW + (16 * kd + 8 * hi) * 2);
                  S = MFMA32(af, bfr, S); }
              if (sj == qh) {
#pragma unroll
                  for (int r = 0; r < 16; ++r) if (crow(r, hi) > r32) S[r] = 0.f; }
#pragma unroll
              for (int ks = 0; ks < 2; ++ks) { const bf16x8 vb = tr_frag(Vi + (32 * sj + 16 * ks + 4 * hi + trq) * VROW + 64 * et + trc, 8 * VROW);
                  Y = MFMA32(pack8(S, ks), vb, Y); }
          }
#pragma unroll
          for (int r = 0; r < 16; ++r) { const int lq = 32 * qh + crow(r, hi);
              *(LAS bf16*)(lds + OFF_Y + lq * VROW + (32 * et + r32) * 2) = (bf16)cvtpk1(Y[r] * __builtin_amdgcn_exp2f(gl * (float)lq)); }
          }
#pragma unroll
          for (int d = 0; d < 2; ++d)
#pragma unroll
              for (int r = 0; r < 16; ++r) Hs[d][r] *= g64;
#pragma unroll
          for (int ks = 0; ks < 4; ++ks) { const bf16x8 vb = tr_frag(Vi + (16 * ks + 8 * hi + trq) * VROW + 64 * et + trc, 4 * VROW);
#pragma unroll
              for (int d = 0; d < 2; ++d) { const bf16x8 ka = tr_frag(Ki + (16 * ks + 8 * hi + trq) * KROW + 64 * d + trc, 4 * KROW);
                  Hs[d] = MFMA32(ka, vb, Hs[d]); } }
        }
        __syncthreads();
        if (MODE == 1) { int tl = tid; asm volatile("" : "+v"(tl)); const int tt = tl >> 3, e0 = (tl & 7) * 16; const int t = t0 + tt;
          float y[16]; float ss = 0.f;
#pragma unroll
          for (int i = 0; i < 2; ++i) { const v4u yw = *(const LAS v4u*)(lds + OFF_Y + tt * VROW + (e0 + 8 * i) * 2);
#pragma unroll
              for (int k = 0; k < 4; ++k) { y[8 * i + 2 * k] = bflo(yw[k]); y[8 * i + 2 * k + 1] = bfhi(yw[k]); ss += y[8 * i + 2 * k] * y[8 * i + 2 * k] + y[8 * i + 2 * k + 1] * y[8 * i + 2 * k + 1]; } }
          ss += SWZ_XOR(ss, 1); ss += SWZ_XOR(ss, 2); ss += SWZ_XOR(ss, 4);
          const float rn = __builtin_amdgcn_rsqf(ss * (1.f / 128.f) + NORM_EPS);
#pragma unroll
          for (int i = 0; i < 2; ++i) { const v4u gw = gz[i];
              const f32x4 g0 = *(const f32x4*)(gain + e0 + 8 * i), g1 = *(const f32x4*)(gain + e0 + 8 * i + 4);
              v4u w; w.x = cvtpk(y[8 * i + 0] * rn * g0.x * silu_fast(bflo(gw.x)), y[8 * i + 1] * rn * g0.y * silu_fast(bfhi(gw.x)));
              w.y = cvtpk(y[8 * i + 2] * rn * g0.z * silu_fast(bflo(gw.y)), y[8 * i + 3] * rn * g0.w * silu_fast(bfhi(gw.y)));
              w.z = cvtpk(y[8 * i + 4] * rn * g1.x * silu_fast(bflo(gw.z)), y[8 * i + 5] * rn * g1.y * silu_fast(bfhi(gw.z)));
              w.w = cvtpk(y[8 * i + 6] * rn * g1.z * silu_fast(bflo(gw.w)), y[8 * i + 7] * rn * g1.w * silu_fast(bfhi(gw.w)));
              *(v4u*)(MIX + (size_t)t * DM + h * 128 + e0 + 8 * i) = w; } }
    }
#undef RET_PREFETCH
    if (MODE == 0) {
        if (qh == 0) { int tl = tid; asm volatile("" : "+v"(tl)); const int lane = tl & 63;
          float* dst = RS + ((size_t)((unit32 * 8 + seg) * 4 + et) * 8) * 256 + lane * 4;
#pragma unroll
          for (int d = 0; d < 2; ++d)
#pragma unroll
              for (int rq = 0; rq < 4; ++rq) *(f32x4*)(dst + (d * 4 + rq) * 256) = (f32x4){Hs[d][4 * rq + 0], Hs[d][4 * rq + 1], Hs[d][4 * rq + 2], Hs[d][4 * rq + 3]}; }
        asm volatile("s_waitcnt vmcnt(0)" ::: "memory");
        __syncthreads();
        if (tid == 0) { __builtin_amdgcn_fence(__ATOMIC_RELEASE, "agent"); asm volatile("s_waitcnt vmcnt(0)" ::: "memory");
            __hip_atomic_store(flags + seg * 64, 1u, __ATOMIC_RELAXED, __HIP_MEMORY_SCOPE_AGENT); }
    }
}

template <int DIL>
__device__ __forceinline__ void dil_loadq(bf16x8 (&qn)[4], const bf16* P, int h, int rs, int blk, int tid) {
    int tl = tid; asm volatile("" : "+v"(tl));
    const int lane = tl & 63; const int tq = (256 * blk + 32 * (tl >> 6) + (lane & 31)) * DIL + rs; const bf16* qrow = P + (size_t)((tq & 15) * 256 + (tq >> 4)) * 192;
#pragma unroll
    for (int s = 0; s < 4; ++s) qn[s] = *(const bf16x8*)(qrow + 16 * s + 8 * (lane >> 5));
}
template <int DIL>
__device__ __forceinline__ void dil_load(v4u (&pre)[12], const bf16* P, int h, int rs, int blk, int tid) {
    int tl = tid; asm volatile("" : "+v"(tl));
    const int m0 = 256 * blk - 128;
#pragma unroll
    for (int i = 0; i < 12; ++i) { const int idx = tl + 512 * i; const int which = i >= 6 ? 1 : 0; const int j = idx - which * 3072; const int row = j >> 3, ch = j & 7; const int mk = m0 + row;
        const int tk = mk * DIL + rs;
        pre[i] = (mk >= 0) ? *(const v4u*)(P + (size_t)((tk & 15) * 256 + (tk >> 4)) * 192 + (which ? 128 : 64) + ch * 8) : (v4u){0u, 0u, 0u, 0u}; }
}
__device__ __forceinline__ void dil_write(const v4u (&pre)[12], LAS unsigned char* lds, int tid) {
    constexpr int ROW = 144, IMG = 384 * ROW;
    int tl = tid; asm volatile("" : "+v"(tl));
#pragma unroll
    for (int i = 0; i < 12; ++i) { const int idx = tl + 512 * i; const int which = i >= 6 ? 1 : 0; const int j = idx - which * 3072; const int row = j >> 3, ch = j & 7;
        *(LAS v4u*)(lds + which * IMG + row * ROW + ch * 16) = pre[i]; }
}
template <int DIL>
__device__ __forceinline__ void dil_compute(const Args& a, bf16x8 (&qf)[4], int b, int h, int rs, int blk, int nrs, int nblk, bool has_next, LAS unsigned char* lds, int tid) {
    constexpr int ROW = 144, IMG = 384 * ROW;
    constexpr int PIDX = DIL == 4 ? 0 : 1;
    const bf16* P = (const bf16*)(a.ws + WS_DQKV) + (size_t)(b * 8 + h) * (SEQ * 192);
    bf16* OP = (bf16*)((unsigned char*)a.out + OS_DILO); float* LSE = (float*)((unsigned char*)a.out + OS_DILL);
    const int m0 = 256 * blk - 128;
    { int tl = tid; asm volatile("" : "+v"(tl)); const int lane = tl & 63, r32 = lane & 31, hi = lane >> 5, trq = (lane & 15) >> 2;
      const int w = __builtin_amdgcn_readfirstlane(tl >> 6);
      const int trc = (16 * ((lane >> 4) & 1) + 4 * (lane & 3)) * 2;
      const int mq = 256 * blk + 32 * w + r32; const int tq = mq * DIL + rs;
      lds_cptr Ki = (lds_cptr)lds, Vi = (lds_cptr)(lds + IMG);
      const size_t grow = (size_t)b * SEQ + tq;
      constexpr float c1 = 0.125f * 1.4426950408889634f;
      const float sl2 = exp2f(-(float)(h + 1)) * (float)DIL * 1.4426950408889634f;
      f32x16 CRS;
#pragma unroll
      for (int r = 0; r < 16; ++r) CRS[r] = (sl2 * (1.f / c1)) * (float)crow(r, hi);
      f32x16 S[5];
#pragma unroll
      for (int j = 0; j < 5; ++j) {
#pragma unroll
          for (int s = 0; s < 4; ++s) { const bf16x8 kf = *(const LAS bf16x8*)(Ki + (32 * w + 32 * j + r32) * ROW + (16 * s + 8 * hi) * 2); S[j] = MFMA32(kf, qf[s], s == 0 ? CRS : S[j]); } }
      __builtin_amdgcn_sched_barrier(0);
      if (has_next) dil_loadq<DIL>(qf, P, h, nrs, nblk, tid);
#pragma unroll
      for (int r = 0; r < 16; ++r) { if (crow(r, hi) < r32) S[0][r] = -1e30f; if (crow(r, hi) > r32) S[4][r] = -1e30f; }
      if (blk == 0) {
#pragma unroll
          for (int j = 0; j < 4; ++j)
#pragma unroll
              for (int r = 0; r < 16; ++r) if (32 * w + 32 * j + crow(r, hi) < 128) S[j][r] = -1e30f; }
      float bjs[5]; float mt = -1e30f;
#pragma unroll
      for (int j = 0; j < 5; ++j) { bjs[j] = -sl2 * (float)(128 + r32 - 32 * j); float mj = S[j][0];
#pragma unroll
          for (int r = 1; r < 16; ++r) mj = fmaxf(mj, S[j][r]);
          mt = fmaxf(mt, mj * c1 + bjs[j]); }
      mt = swap32_max(mt);
      float ls = 0.f;
#pragma unroll
      for (int j = 0; j < 5; ++j) { const float aj = bjs[j] - mt;
#pragma unroll
          for (int r = 0; r < 16; ++r) { const float p = __builtin_amdgcn_exp2f(S[j][r] * c1 + aj); S[j][r] = p; ls += p; } }
      ls = swap32_sum(ls);
      float l1 = 0.f, l2 = 0.f; v2u a1[8], a2[8];
      if (DIL == 1) { l1 = LSE[((size_t)0 * M + grow) * 8 + h]; l2 = LSE[((size_t)1 * M + grow) * 8 + h];
          const bf16* o1 = OP + ((size_t)0 * M + grow) * 512 + h * 64; const bf16* o2 = OP + ((size_t)1 * M + grow) * 512 + h * 64;
#pragma unroll
          for (int d = 0; d < 2; ++d)
#pragma unroll
              for (int rg = 0; rg < 4; ++rg) { const int d0 = 32 * d + 8 * rg + 4 * hi; a1[d * 4 + rg] = *(const v2u*)(o1 + d0); a2[d * 4 + rg] = *(const v2u*)(o2 + d0); } }
      f32x16 O[2];
#pragma unroll
      for (int d = 0; d < 2; ++d)
#pragma unroll
          for (int r = 0; r < 16; ++r) O[d][r] = 0.f;
#pragma unroll
      for (int j = 0; j < 5; ++j)
#pragma unroll
          for (int ks = 0; ks < 2; ++ks) { const bf16x8 pf = pack8(S[j], ks);
#pragma unroll
              for (int d = 0; d < 2; ++d) { const bf16x8 vf = tr_frag(Vi + (32 * w + 32 * j + 16 * ks + 4 * hi + trq) * ROW + 64 * d + trc, 8 * ROW); O[d] = MFMA32(vf, pf, O[d]); } }
      const float il = 1.f / ls; const float lse2 = mt + __builtin_amdgcn_logf(ls);
      if (DIL != 1) {
          bf16* orow = OP + ((size_t)PIDX * M + grow) * 512 + h * 64;
#pragma unroll
          for (int d = 0; d < 2; ++d)
#pragma unroll
              for (int rg = 0; rg < 4; ++rg) { v2u wv; wv.x = cvtpk(O[d][4 * rg] * il, O[d][4 * rg + 1] * il); wv.y = cvtpk(O[d][4 * rg + 2] * il, O[d][4 * rg + 3] * il);
                  *(v2u*)(orow + 32 * d + 8 * rg + 4 * hi) = wv; }
          if (hi == 0) LSE[((size_t)PIDX * M + grow) * 8 + h] = lse2;
      } else {
          const float mm = fmaxf(lse2, fmaxf(l1, l2));
          const float w0 = __builtin_amdgcn_exp2f(lse2 - mm), w1 = __builtin_amdgcn_exp2f(l1 - mm), w2 = __builtin_amdgcn_exp2f(l2 - mm);
          const float iw = 1.f / (w0 + w1 + w2);
          const float f0 = w0 * iw * il, f1 = w1 * iw, f2 = w2 * iw;
          bf16* mrow = (bf16*)(a.ws + WS_MIX) + grow * DM + 1536 + h * 64;
#pragma unroll
          for (int d = 0; d < 2; ++d)
#pragma unroll
              for (int rg = 0; rg < 4; ++rg) { const int d0 = 32 * d + 8 * rg + 4 * hi; const v2u p1 = a1[d * 4 + rg], p2 = a2[d * 4 + rg];
                  v2u wv; wv.x = cvtpk(O[d][4 * rg] * f0 + bflo(p1.x) * f1 + bflo(p2.x) * f2, O[d][4 * rg + 1] * f0 + bfhi(p1.x) * f1 + bfhi(p2.x) * f2);
                  wv.y = cvtpk(O[d][4 * rg + 2] * f0 + bflo(p1.y) * f1 + bflo(p2.y) * f2, O[d][4 * rg + 3] * f0 + bfhi(p1.y) * f1 + bfhi(p2.y) * f2);
                  *(v2u*)(mrow + d0) = wv; }
      }
    }
}
template <int DIL>
__device__ __forceinline__ void dil_unit_mfma(const Args& a, int l, int b, int h, int part, LAS unsigned char* lds, int tid) {
    asm volatile("" : "+v"(tid));
    const bf16* P = (const bf16*)(a.ws + WS_DQKV) + (size_t)(b * 8 + h) * (SEQ * 192);
    unsigned* flags = (unsigned*)(a.ws + WS_CTL) + CW_FLAG3 + (size_t)((l * 64 + b * 8 + h) * 4) * 64;
    const int i0 = (part & 1) * 8;
#define DIL_RS(i) (DIL == 16 ? (i) : (DIL == 4 ? ((i) & 3) : 0))
#define DIL_BLK(i) (DIL == 16 ? 0 : (DIL == 4 ? ((i) >> 2) : (i)))
    v4u pre[12]; bf16x8 qf[4];
    dil_load<DIL>(pre, P, h, DIL_RS(i0), DIL_BLK(i0), tid);
    dil_loadq<DIL>(qf, P, h, DIL_RS(i0), DIL_BLK(i0), tid);
    if (DIL == 1) {
        if (tid == 0) { for (int j = 0; j < 4; ++j) { unsigned sp = 0; while (__hip_atomic_load(flags + j * 64, __ATOMIC_RELAXED, __HIP_MEMORY_SCOPE_AGENT) == 0u) { __builtin_amdgcn_s_sleep(2); if (++sp > (1u << 22)) break; } }
            __builtin_amdgcn_fence(__ATOMIC_ACQUIRE, "agent"); asm volatile("s_waitcnt vmcnt(0)" ::: "memory"); }
    }
    for (int i = i0; i < i0 + 8; ++i) {
        dil_write(pre, lds, tid);
        __syncthreads();
        const bool hn = i + 1 < i0 + 8;
        if (hn) dil_load<DIL>(pre, P, h, DIL_RS(i + 1), DIL_BLK(i + 1), tid);
        dil_compute<DIL>(a, qf, b, h, DIL_RS(i), DIL_BLK(i), DIL_RS(i + 1), DIL_BLK(i + 1), hn, lds, tid);
        __syncthreads();
    }
#undef DIL_RS
#undef DIL_BLK
    if (DIL != 1) {
        asm volatile("s_waitcnt vmcnt(0)" ::: "memory");
        __syncthreads();
        if (tid == 0) { __builtin_amdgcn_fence(__ATOMIC_RELEASE, "agent"); asm volatile("s_waitcnt vmcnt(0)" ::: "memory");
            __hip_atomic_store(flags + part * 64, 1u, __ATOMIC_RELAXED, __HIP_MEMORY_SCOPE_AGENT); }
    }
}

__device__ __forceinline__ void mixer_phase(const Args& a, int l, LAS unsigned char* lds, int tid, int G) {
    const float lam_init = 0.8f - 0.6f * expf(-0.3f * (float)l);
    float lam;
    { const float* lf = a.in[10] + l * 256; const int lane = tid & 63;
      const float s1 = wave_sum(lf[lane] * lf[64 + lane]), s2 = wave_sum(lf[128 + lane] * lf[192 + lane]);
      lam = expf(s1) - expf(s2) + lam_init; }
    volatile LAS int* qslot = (volatile LAS int*)(lds + MISC_OFF + 64);
    unsigned* ctr = (unsigned*)(a.ws + WS_CTL) + CW_Q + 64 * l;
    constexpr int U_KN = 16, U_SSA = U_KN + 112, U_RTA = U_SSA + 224, U_D16 = U_RTA + 128, U_D4 = U_D16 + 128, U_SSB = U_D4 + 128, U_RET = U_SSB + 256, U_DL2 = U_RET + 128, U_END = U_DL2 + 1024;
#define Q_NEXT() do { __syncthreads(); if (tid == 0) *qslot = (int)__hip_atomic_fetch_add(ctr, 1u, __ATOMIC_RELAXED, __HIP_MEMORY_SCOPE_AGENT); __syncthreads(); u = *qslot; } while (0)
    int u; Q_NEXT();
    while (u < U_KN) { kn_unit(a, l, u >> 1, u & 1, tid); Q_NEXT(); }
    while (u < U_SSA) { const int v = u - U_KN; const int sg = v >> 4, bg = v & 15; ssd_unit_mfma<0>(a, l, bg >> 1, bg & 1, sg, lds, tid); Q_NEXT(); }
    while (u < U_RTA) { const int v = u - U_SSA; const int sg = v >> 5, bh = v & 31; ret_unit_mfma<0>(a, l, bh >> 2, bh & 3, sg, lds, tid); Q_NEXT(); }
    while (u < U_D16) { const int v = u - U_RTA; const int part = v >> 6, bh = v & 63; dil_unit_mfma<16>(a, l, bh >> 3, bh & 7, part, lds, tid); Q_NEXT(); }
    while (u < U_D4) { const int v = u - U_D16; const int part = 2 + (v >> 6), bh = v & 63; dil_unit_mfma<4>(a, l, bh >> 3, bh & 7, part, lds, tid); Q_NEXT(); }
    while (u < U_SSB) { const int v = u - U_D4; const int sg = v >> 4, bg = v & 15; ssd_unit_mfma<1>(a, l, bg >> 1, bg & 1, sg, lds, tid); Q_NEXT(); }
    while (u < U_RET) { const int v = u - U_SSB; const int sg = v >> 5, bh = v & 31; ret_unit_mfma<1>(a, l, bh >> 2, bh & 3, sg, lds, tid); Q_NEXT(); }
    while (u < U_DL2) { const int v = u - U_RET; const int part = 4 + (v >> 6), bh = v & 63; dil_unit_mfma<1>(a, l, bh >> 3, bh & 7, part, lds, tid); Q_NEXT(); }
    while (u < U_END) { const int v = u - U_DL2; const int qb = 31 - (v >> 5), bh = v & 31; diff_unit_mfma(a, l, bh >> 2, bh & 3, qb, lam, lam_init, lds, tid); Q_NEXT(); }
    int ucv = U_END;
    if (l == 0) { constexpr int NU0 = (CVT_NITEMS - CVT_I_IN) / 64;
        const int wv = __builtin_amdgcn_readfirstlane(tid >> 6);
        while (u < U_END + NU0) { const int i0 = CVT_I_IN + (u - U_END) * 64; convert_weights(a, 0, lds, i0 + wv, i0 + 64, 8, wv, tid & 63); Q_NEXT(); }
        ucv = U_END + NU0; }
    if (l + 1 < DEPTH) { const int U_CVT = ucv + (CVT_NITEMS + 63) / 64;
        const int wv = __builtin_amdgcn_readfirstlane(tid >> 6);
        while (u < U_CVT) { const int i0 = (u - ucv) * 64; convert_weights(a, l + 1, lds, i0 + wv, (i0 + 64 < CVT_NITEMS ? i0 + 64 : CVT_NITEMS), 8, wv, tid & 63); Q_NEXT(); } }
#undef Q_NEXT
}

__global__ void __launch_bounds__(NWAVES * 64, 2) hybrid_fwd(Args args) {
    extern __shared__ __attribute__((aligned(16))) unsigned char lds_raw[];
    LAS unsigned char* lds = (LAS unsigned char*)lds_raw;
    volatile LAS unsigned* MISC = (volatile LAS unsigned*)(lds + MISC_OFF);
    const int tid = threadIdx.x, lane = tid & 63, wave = __builtin_amdgcn_readfirstlane(tid >> 6);
    const int G = gridDim.x;
    const int vcu = (G % 8 == 0) ? ((int)blockIdx.x % 8) * (G / 8) + (int)blockIdx.x / 8 : (int)blockIdx.x;
    const int gw = vcu * NWAVES + wave, NGW = G * NWAVES;
    unsigned char* ws = args.ws;
    gu32* ctl = (gu32*)(ws + WS_CTL);
    for (int u = tid; u < (LDS_BYTES - LDSCTL_OFF) / 4; u += NWAVES * 64) ((LAS unsigned*)(lds + LDSCTL_OFF))[u] = 0u;
    __syncthreads();
    XcdBarrier bar; bar.bar = (unsigned*)(ctl + CW_BAR); bar.x = 0; bar.st = nullptr;
    if (MK_N_LAUNCHES == 1) bar = xcd_barrier_post((unsigned*)(ctl + CW_BAR), MISC + 8);
#define GRID_BAR() do { if (MK_N_LAUNCHES == 1) xcd_barrier(bar); } while (0)
    const int lo = args.ph_lo, hi = args.ph_hi;
#define IN(k) (lo <= (k) && (k) < hi)
#define BOTH(k) (IN(k) && IN((k) + 1))
    bf16* H = (bf16*)(ws + WS_XB); float* RINV = (float*)(ws + WS_RINV); bf16* MIXB = (bf16*)(ws + WS_MIX); bf16* PROJ = (bf16*)(ws + WS_PROJ);
    bf16* Y1 = PROJ; bf16* HID = PROJ; bf16* Y2 = MIXB;

    if (IN(0)) {
        convert_weights(args, 0, lds, gw, CVT_I_IN, NGW, wave, lane);
        thin_rows<0>(args.in[0], H, RINV, nullptr, nullptr, nullptr, gw, NGW, lane, args.in[2] + 3072, args.in[1], (float*)(ws + WS_DT), lds);
        if (BOTH(0)) GRID_BAR();
    }
#define LAYER_BODY(l) do { \
        const int pb = 1 + 7 * (l); \
        if (IN(pb)) { \
            pg8::Gemm g{H, (const bf16*)(ws + WS_W0 + (size_t)((l) & 1) * WBUF + WO_IN), M, LDP, DM}; pg8::StaticOrder S; S.init(M, LDP, G, (int)blockIdx.x); \
            pg8::EpiProj E{PROJ, LDP, (bf16*)(ws + WS_DQKV)}; \
            pg8::gemm_phase<pg8::EpiProj, pg8::StaticOrder, true, true>(lds + RING_OFF, g, S, E); \
            if (BOTH(pb)) GRID_BAR(); \
        } \
        if (IN(pb + 1)) { \
            mixer_phase(args, l, lds, tid, G); \
            if (BOTH(pb + 1)) GRID_BAR(); \
        } \
        if (IN(pb + 2)) { \
            pg8::Gemm g{MIXB, (const bf16*)(ws + WS_W0 + (size_t)((l) & 1) * WBUF + WO_OUT), M, DM, DM}; pg8::StaticOrder S; S.init(M, DM, G, (int)blockIdx.x); \
            pg8::EpiBf16 E{Y1, DM}; \
            pg8::gemm_phase<pg8::EpiBf16, pg8::StaticOrder, true, true>(lds + RING_OFF, g, S, E); \
            if (BOTH(pb + 2)) GRID_BAR(); \
        } \
        if (IN(pb + 3)) { \
            thin_rows<1>(nullptr, H, RINV, Y1, args.in[13] + l * DM, nullptr, gw, NGW, lane); \
            if (BOTH(pb + 3)) GRID_BAR(); \
        } \
        if (IN(pb + 4)) { \
            pg8::Gemm g{H, (const bf16*)(ws + WS_W0 + (size_t)((l) & 1) * WBUF + WO_GU), M, 2 * FFN, DM}; pg8::StaticOrder S; S.init(M, 2 * FFN, G, (int)blockIdx.x); \
            pg8::EpiSwiGLU E{HID, FFN}; \
            pg8::gemm_phase<pg8::EpiSwiGLU, pg8::StaticOrder, true, true>(lds + RING_OFF, g, S, E); \
            if (BOTH(pb + 4)) GRID_BAR(); \
        } \
        if (IN(pb + 5)) { \
            pg8::Gemm g{HID, (const bf16*)(ws + WS_W0 + (size_t)((l) & 1) * WBUF + WO_D), M, DM, FFN}; pg8::StaticOrder S; S.init(M, DM, G, (int)blockIdx.x); \
            pg8::EpiBf16 E{Y2, DM}; \
            pg8::gemm_phase<pg8::EpiBf16, pg8::StaticOrder, true, true>(lds + RING_OFF, g, S, E); \
            if (BOTH(pb + 5)) GRID_BAR(); \
        } \
        if (IN(pb + 6)) { \
            if ((l) + 1 < DEPTH) thin_rows<1>(nullptr, H, RINV, Y2, args.in[18] + l * DM, nullptr, gw, NGW, lane, args.in[2] + (size_t)((l) + 1 < DEPTH ? (l) + 1 : 0) * DM * IN_COLS + 3072, args.in[1] + ((l) + 1 < DEPTH ? (l) + 1 : 0) * DM, (float*)(ws + WS_DT), lds); \
            else thin_rows<2>(nullptr, H, RINV, Y2, args.in[18] + l * DM, args.out, gw, NGW, lane); \
            if (BOTH(pb + 6)) GRID_BAR(); \
        } \
    } while (0)
    LAYER_BODY(0); LAYER_BODY(1); LAYER_BODY(2); LAYER_BODY(3);
#undef LAYER_BODY
#undef IN
#undef BOTH
#undef GRID_BAR
}

extern "C" void kernel_launch(void* const* d_in, const int* in_sizes, int n_in, void* d_out, int out_size, void* d_ws, size_t ws_size, hipStream_t stream) {
    static int grid = 0;
    if (grid == 0) {
        if (n_in != 19 || in_sizes[0] != M * DM || out_size != M * DM || ws_size < WS_END) { fprintf(stderr, "kernel_launch: unexpected shapes (n_in %d, in0 %d, out %d, ws %zu); nothing launched\n", n_in, n_in > 0 ? in_sizes[0] : -1, out_size, ws_size); grid = -1; return; }
        int dev = 0, cus = 0, per_cu = 0;
        if (hipGetDevice(&dev) != hipSuccess || hipDeviceGetAttribute(&cus, hipDeviceAttributeMultiprocessorCount, dev) != hipSuccess) { grid = -1; return; }
        if (hipFuncSetAttribute((const void*)hybrid_fwd, hipFuncAttributeMaxDynamicSharedMemorySize, LDS_BYTES) != hipSuccess) { fprintf(stderr, "kernel_launch: hipFuncSetAttribute failed\n"); grid = -1; return; }
        if (hipOccupancyMaxActiveBlocksPerMultiprocessor(&per_cu, (const void*)hybrid_fwd, NWAVES * 64, LDS_BYTES) != hipSuccess || per_cu < 1)
            fprintf(stderr, "kernel_launch: note: occupancy query reports %d workgroups per CU\n", per_cu);
        (void)hipGetLastError();
        grid = cus;
    }
    if (grid < 0) return;
    if (hipMemsetAsync((char*)d_ws + WS_CTL, 0, CTL_ZERO_BYTES, stream) != hipSuccess) return;
    Args a{};
    for (int i = 0; i < 19; ++i) a.in[i] = (const float*)d_in[i];
    a.out = (float*)d_out; a.ws = (unsigned char*)d_ws; a.pad = 0;
    if (MK_N_LAUNCHES == 1) {
        a.ph_lo = 0; a.ph_hi = N_PHASES; a.li = 0;
        hipLaunchKernelGGL(hybrid_fwd, dim3(grid), dim3(NWAVES * 64), LDS_BYTES, stream, a);
    } else {
        for (int li = 0; li < N_PHASES; ++li) { a.ph_lo = li; a.ph_hi = li + 1; a.li = li;
            hipLaunchKernelGGL(hybrid_fwd, dim3(grid), dim3(NWAVES * 64), LDS_BYTES, stream, a); }
    }
}
```
